# Optimizing an MI355X kernel written in HIP

```python
import jax, jax.numpy as jnp
from jax import lax
import numpy as np

D_MODEL = 1024
BATCH = 4
SEQ = 8192
DEPTH = 2

EPS = 1e-6
HEAD_DIM = 64
ATTN_Q_HEADS = 8
ATTN_KV_HEADS = 2
ATTN_GROUP = ATTN_Q_HEADS // ATTN_KV_HEADS
ATTN_WIDTH = ATTN_Q_HEADS * HEAD_DIM
KV_WIDTH = ATTN_KV_HEADS * HEAD_DIM
WINDOW = 128
ATTN_BLOCK = WINDOW
ROPE_THETA = 10000.0
SSM_HEADS = 8
SSM_HEAD_DIM = 64
SSM_WIDTH = SSM_HEADS * SSM_HEAD_DIM
SSM_GROUPS = 2
SSM_HEADS_PER_GROUP = SSM_HEADS // SSM_GROUPS
SSM_STATE = 128
CONV_WIDTH = 4
CONV_CH = SSM_WIDTH + 2 * SSM_GROUPS * SSM_STATE
CHUNK = 128
MIX_WIDTH = ATTN_WIDTH + SSM_WIDTH
IN_WIDTH = ATTN_WIDTH + 2 * KV_WIDTH + SSM_WIDTH + CONV_CH + SSM_HEADS
IN_SPLITS = [ATTN_WIDTH,
             ATTN_WIDTH + KV_WIDTH,
             ATTN_WIDTH + 2 * KV_WIDTH,
             ATTN_WIDTH + 2 * KV_WIDTH + SSM_WIDTH,
             ATTN_WIDTH + 2 * KV_WIDTH + SSM_WIDTH + CONV_CH]
FFN_DIM = 2816
N_EXPERTS = 8
TOP_K = 2
EXPERT_DIM = 3584
MOE_BLOCK = 256
N_DENSE = (DEPTH + 1) // 2
N_MOE = DEPTH // 2

kernel_name = "hymba_swa_sink_ssd_moe_adaln"


def rms_norm(x, g):
    xf = x.astype(jnp.float32)
    y = xf * lax.rsqrt(jnp.mean(xf * xf, axis=-1, keepdims=True) + EPS)
    return (y * g.astype(jnp.float32)).astype(x.dtype)


def modulate(h, shift, scale):
    return h * (1 + scale[:, None, :]) + shift[:, None, :]


def apply_rope(t, cos, sin):
    tf = t.astype(jnp.float32)
    t1, t2 = jnp.split(tf, 2, axis=-1)
    return jnp.concatenate([t1 * cos - t2 * sin, t2 * cos + t1 * sin], axis=-1).astype(t.dtype)


def sliding_window_attention(q, k, v, sinks):
    b, s = q.shape[:2]
    nb = s // ATTN_BLOCK
    qb = q.reshape(b, nb, ATTN_BLOCK, ATTN_KV_HEADS, ATTN_GROUP, HEAD_DIM)
    kb = k.reshape(b, nb, ATTN_BLOCK, ATTN_KV_HEADS, HEAD_DIM)
    vb = v.reshape(b, nb, ATTN_BLOCK, ATTN_KV_HEADS, HEAD_DIM)

    def with_prev(t):
        prev = jnp.pad(t[:, :-1], ((0, 0), (1, 0), (0, 0), (0, 0), (0, 0)))
        return jnp.concatenate([prev, t], axis=2)

    kk, vv = with_prev(kb), with_prev(vb)
    scores = jnp.einsum('bnqhgd,bnkhd->bhgnqk', qb, kk).astype(jnp.float32) * (HEAD_DIM ** -0.5)
    qi = jnp.arange(ATTN_BLOCK)[:, None]
    kj = jnp.arange(2 * ATTN_BLOCK)[None, :]
    delta = ATTN_BLOCK + qi - kj
    band = (delta >= 0) & (delta < WINDOW)
    key_valid = (jnp.arange(nb)[:, None] * ATTN_BLOCK - ATTN_BLOCK + kj) >= 0
    mask = band[None] & key_valid[:, None, :]
    scores = jnp.where(mask, scores, -jnp.inf)
    sink = sinks.astype(jnp.float32).reshape(ATTN_KV_HEADS, ATTN_GROUP)[None, :, :, None, None, None]
    m = jnp.maximum(jnp.max(scores, axis=-1, keepdims=True), sink)
    p = jnp.exp(scores - m)
    denom = jnp.sum(p, axis=-1, keepdims=True) + jnp.exp(sink - m)
    out = jnp.einsum('bhgnqk,bnkhd->bnqhgd', p / denom, vv.astype(jnp.float32))
    return out.reshape(b, s, ATTN_WIDTH).astype(q.dtype)


def causal_depthwise_conv(u, w, bias):
    out = lax.conv_general_dilated(
        u, w[:, None, :].astype(u.dtype), window_strides=(1,),
        padding=[(CONV_WIDTH - 1, 0)], dimension_numbers=('NWC', 'WIO', 'NWC'),
        feature_group_count=CONV_CH)
    return out + bias.astype(u.dtype)


def ssd_chunked(x, dt, a, b_mat, c_mat):
    bsz, s = x.shape[:2]
    nc = s // CHUNK
    g, r, p_, n = SSM_GROUPS, SSM_HEADS_PER_GROUP, SSM_HEAD_DIM, SSM_STATE
    xd = (x.astype(jnp.float32) * dt[..., None]).reshape(bsz, nc, CHUNK, g, r, p_)
    a_cs = jnp.cumsum((dt * a).reshape(bsz, nc, CHUNK, g, r), axis=2)
    bc = b_mat.astype(jnp.float32).reshape(bsz, nc, CHUNK, g, n)
    cc = c_mat.astype(jnp.float32).reshape(bsz, nc, CHUNK, g, n)
    seg = a_cs[:, :, :, None] - a_cs[:, :, None, :]
    causal = jnp.tril(jnp.ones((CHUNK, CHUNK), dtype=bool))[:, :, None, None]
    decay = jnp.exp(jnp.where(causal, seg, -jnp.inf))
    cb = jnp.einsum('bclgn,bcsgn->bclsg', cc, bc)
    y_diag = jnp.einsum('bclsgr,bcsgrp->bclgrp', cb[..., None] * decay, xd)
    decay_to_end = jnp.exp(a_cs[:, :, -1:] - a_cs)
    chunk_states = jnp.einsum('bclgn,bclgrp->bcgrpn', bc, xd * decay_to_end[..., None])
    chunk_decay = jnp.exp(a_cs[:, :, -1])

    def step(h, inp):
        st, dec = inp
        return dec[..., None, None] * h + st, h

    h0 = jnp.zeros((bsz, g, r, p_, n), jnp.float32)
    _, h_prev = lax.scan(step, h0, (jnp.moveaxis(chunk_states, 1, 0), jnp.moveaxis(chunk_decay, 1, 0)))
    h_prev = jnp.moveaxis(h_prev, 0, 1)
    y_off = jnp.einsum('bclgn,bcgrpn->bclgrp', cc, h_prev) * jnp.exp(a_cs)[..., None]
    return (y_diag + y_off).reshape(bsz, s, SSM_HEADS, SSM_HEAD_DIM)


def swiglu(h, w_gate, w_up, w_down):
    return (jax.nn.silu(h @ w_gate) * (h @ w_up)) @ w_down


def moe_swiglu(h, router_w, w_gate, w_up, w_down):
    b, s, d = h.shape
    t = b * s
    hf = h.reshape(t, d)
    logits = (hf @ router_w).astype(jnp.float32)
    top_val, top_idx = lax.top_k(logits, TOP_K)
    gates = jax.nn.softmax(top_val, axis=-1)
    tk = t * TOP_K
    e_flat = top_idx.reshape(tk).astype(jnp.int32)
    g_flat = gates.reshape(tk)
    e_s, order = lax.sort((e_flat, jnp.arange(tk, dtype=jnp.int32)), num_keys=1, is_stable=True)
    tok_s = order // TOP_K
    g_s = g_flat[order]
    counts = jnp.bincount(e_flat, length=N_EXPERTS).astype(jnp.int32)
    padded = (counts + MOE_BLOCK - 1) // MOE_BLOCK * MOE_BLOCK
    pad_end = jnp.cumsum(padded)
    pad_start = pad_end - padded
    start = jnp.cumsum(counts) - counts
    dest = pad_start[e_s] + jnp.arange(tk, dtype=jnp.int32) - start[e_s]
    n_rows = (tk + MOE_BLOCK - 1) // MOE_BLOCK * MOE_BLOCK + N_EXPERTS * MOE_BLOCK
    n_blocks = n_rows // MOE_BLOCK
    row_tok = jnp.full((n_rows,), t, jnp.int32).at[dest].set(tok_s)
    row_gate = jnp.zeros((n_rows,), jnp.float32).at[dest].set(g_s)
    block_expert = jnp.minimum(
        jnp.searchsorted(pad_end, jnp.arange(n_blocks, dtype=jnp.int32) * MOE_BLOCK, side='right'),
        N_EXPERTS - 1)
    h_pad = jnp.concatenate([hf, jnp.zeros((1, d), hf.dtype)], axis=0)
    xb = h_pad[row_tok].reshape(n_blocks, MOE_BLOCK, d)

    def expert_block(args):
        xblk, e = args
        return swiglu(xblk, w_gate[e], w_up[e], w_down[e])

    yb = lax.map(expert_block, (xb, block_expert)).reshape(n_rows, d)
    out = jnp.zeros((t + 1, d), h.dtype).at[row_tok].add((yb * row_gate[:, None]).astype(h.dtype))
    return out[:t].reshape(b, s, d)


def setup_inputs(seed: int = 0) -> dict:
    key = jax.random.key(seed)
    ks = jax.random.split(key, 32)
    f32 = jnp.float32
    nrm = lambda k, shape, scale: jax.random.normal(k, shape, f32) * scale
    x = jax.random.normal(ks[0], (BATCH, SEQ, D_MODEL), f32)
    c = jax.random.normal(ks[1], (BATCH, D_MODEL), f32)
    offsets = jax.random.randint(ks[2], (BATCH, 1), 0, 4096, dtype=jnp.int32)
    positions = offsets + jnp.arange(SEQ, dtype=jnp.int32)[None, :]
    dt0 = jnp.exp(jax.random.uniform(ks[3], (DEPTH, SSM_HEADS), f32) * (np.log(0.1) - np.log(0.001)) + np.log(0.001))
    return {
        "x": x,
        "c": c,
        "positions": positions,
        "ada_w": nrm(ks[4], (DEPTH, D_MODEL, 6 * D_MODEL), 0.5 * D_MODEL ** -0.5),
        "ada_b": nrm(ks[5], (DEPTH, 6 * D_MODEL), 0.02),
        "norm_mix_g": 1.0 + nrm(ks[6], (DEPTH, D_MODEL), 0.02),
        "norm_ffn_g": 1.0 + nrm(ks[7], (DEPTH, D_MODEL), 0.02),
        "w_in": nrm(ks[8], (DEPTH, D_MODEL, IN_WIDTH), D_MODEL ** -0.5),
        "w_out": nrm(ks[9], (DEPTH, MIX_WIDTH, D_MODEL), MIX_WIDTH ** -0.5),
        "attn_sinks": nrm(ks[10], (DEPTH, ATTN_Q_HEADS), 0.5),
        "conv_w": nrm(ks[11], (DEPTH, CONV_WIDTH, CONV_CH), CONV_WIDTH ** -0.5),
        "conv_b": nrm(ks[12], (DEPTH, CONV_CH), 0.02),
        "dt_bias": dt0 + jnp.log(-jnp.expm1(-dt0)),
        "a_log": jnp.log(jax.random.uniform(ks[13], (DEPTH, SSM_HEADS), f32, 1.0, 16.0)),
        "d_skip": 1.0 + nrm(ks[14], (DEPTH, SSM_HEADS), 0.1),
        "ssm_norm_g": 1.0 + nrm(ks[15], (DEPTH, SSM_WIDTH), 0.02),
        "ffn_w_gate": nrm(ks[16], (N_DENSE, D_MODEL, FFN_DIM), D_MODEL ** -0.5),
        "ffn_w_up": nrm(ks[17], (N_DENSE, D_MODEL, FFN_DIM), D_MODEL ** -0.5),
        "ffn_w_down": nrm(ks[18], (N_DENSE, FFN_DIM, D_MODEL), FFN_DIM ** -0.5),
        "router_w": nrm(ks[19], (N_MOE, D_MODEL, N_EXPERTS), D_MODEL ** -0.5),
        "moe_w_gate": nrm(ks[20], (N_MOE, N_EXPERTS, D_MODEL, EXPERT_DIM), D_MODEL ** -0.5),
        "moe_w_up": nrm(ks[21], (N_MOE, N_EXPERTS, D_MODEL, EXPERT_DIM), D_MODEL ** -0.5),
        "moe_w_down": nrm(ks[22], (N_MOE, N_EXPERTS, EXPERT_DIM, D_MODEL), EXPERT_DIM ** -0.5),
        "final_norm_g": 1.0 + nrm(ks[23], (D_MODEL,), 0.02),
    }


def reference(x, c, positions, ada_w, ada_b, norm_mix_g, norm_ffn_g, w_in, w_out,
              attn_sinks, conv_w, conv_b, dt_bias, a_log, d_skip, ssm_norm_g,
              ffn_w_gate, ffn_w_up, ffn_w_down, router_w, moe_w_gate, moe_w_up,
              moe_w_down, final_norm_g):
    f32 = jnp.float32
    b, s, _ = x.shape
    inv_freq = ROPE_THETA ** (-jnp.arange(0, HEAD_DIM, 2, dtype=f32) / HEAD_DIM)
    ang = positions.astype(f32)[..., None] * inv_freq
    cos = jnp.cos(ang)[:, :, None, :]
    sin = jnp.sin(ang)[:, :, None, :]
    c_act = jax.nn.silu(c)
    for l in range(DEPTH):
        mod = c_act @ ada_w[l] + ada_b[l]
        sh_m, sc_m, g_m, sh_f, sc_f, g_f = jnp.split(mod, 6, axis=-1)
        h = modulate(rms_norm(x, norm_mix_g[l]), sh_m, sc_m)
        proj = h @ w_in[l]
        q, k, v, z, xbc, dt_raw = jnp.split(proj, IN_SPLITS, axis=-1)
        q = apply_rope(q.reshape(b, s, ATTN_Q_HEADS, HEAD_DIM), cos, sin)
        k = apply_rope(k.reshape(b, s, ATTN_KV_HEADS, HEAD_DIM), cos, sin)
        v = v.reshape(b, s, ATTN_KV_HEADS, HEAD_DIM)
        attn_out = sliding_window_attention(q, k, v, attn_sinks[l])
        xbc = jax.nn.silu(causal_depthwise_conv(xbc, conv_w[l], conv_b[l]))
        xs, bm, cm = jnp.split(xbc, [SSM_WIDTH, SSM_WIDTH + SSM_GROUPS * SSM_STATE], axis=-1)
        xs = xs.reshape(b, s, SSM_HEADS, SSM_HEAD_DIM)
        dt = jax.nn.softplus(dt_raw.astype(f32) + dt_bias[l].astype(f32))
        a = -jnp.exp(a_log[l].astype(f32))
        y = ssd_chunked(xs, dt, a, bm.reshape(b, s, SSM_GROUPS, SSM_STATE),
                        cm.reshape(b, s, SSM_GROUPS, SSM_STATE))
        y = y + d_skip[l].astype(f32)[:, None] * xs.astype(f32)
        y = y.reshape(b, s, SSM_WIDTH) * jax.nn.silu(z.astype(f32))
        yg = y.reshape(b, s, SSM_GROUPS, SSM_WIDTH // SSM_GROUPS)
        yg = yg * lax.rsqrt(jnp.mean(yg * yg, axis=-1, keepdims=True) + EPS)
        ssm_out = (yg.reshape(b, s, SSM_WIDTH) * ssm_norm_g[l].astype(f32)).astype(x.dtype)
        mixed = jnp.concatenate([attn_out, ssm_out], axis=-1) @ w_out[l]
        x = x + g_m[:, None, :] * mixed
        h = modulate(rms_norm(x, norm_ffn_g[l]), sh_f, sc_f)
        if l % 2 == 0:
            f = swiglu(h, ffn_w_gate[l // 2], ffn_w_up[l // 2], ffn_w_down[l // 2])
        else:
            f = moe_swiglu(h, router_w[l // 2], moe_w_gate[l // 2], moe_w_up[l // 2], moe_w_down[l // 2])
        x = x + g_f[:, None, :] * f
    return rms_norm(x, final_norm_g)
```

```cpp
#include <hip/hip_runtime.h>
#include <stdio.h>

#ifndef MK_MULTI
#define MK_MULTI 0
#endif
#ifndef GEMM_SP2
#define GEMM_SP2 1
#endif
#ifndef WGM_DEF
#define WGM_DEF 3
#endif
#ifndef WGM_GU
#define WGM_GU 2
#endif
#ifndef WGM_N4
#define WGM_N4 2
#endif
#ifndef DENSE_GU_FP8
#define DENSE_GU_FP8 0
#endif
#ifndef FAST_GEMM
#define FAST_GEMM 1
#endif
#ifndef FAST_ATTN
#define FAST_ATTN 1
#endif
#ifndef FAST_SSD
#define FAST_SSD 1
#endif

constexpr int BATCH = 4, SEQ = 8192, T = BATCH * SEQ, D = 1024;
constexpr int NPROJ = 2304, INW = 2312;
constexpr int C_Q = 0, C_K = 512, C_V = 640, C_Z = 768, C_XS = 1280, C_B = 1792, C_C = 2048;
constexpr int FFN = 2816, EXPD = 3584, NEXP = 8;
constexpr int MOE_ROWS = 2 * T + NEXP * 256;
constexpr int CHB = 64;
constexpr int NCHUNK = 5;
constexpr float EPS = 1e-6f;

constexpr size_t MiB = 1u << 20;
constexpr size_t WS_CTL = 0, CTL_BYTES = 1 * MiB;
constexpr size_t WS_MOD = 1 * MiB;
constexpr size_t WS_COS = 2 * MiB, WS_SIN = 6 * MiB;
constexpr size_t WS_TOKE = 10 * MiB;
constexpr size_t WS_TOKG = WS_TOKE + 256 * 1024;
constexpr size_t WS_TOKD = WS_TOKG + 256 * 1024;
constexpr size_t WS_ROWTOK = WS_TOKD + 256 * 1024;
constexpr size_t WS_META = WS_ROWTOK + 512 * 1024;
constexpr size_t WS_WGCNT = WS_META + 4096;
constexpr size_t WS_DT = 12 * MiB;
constexpr size_t WS_ACS = 13 * MiB;
constexpr size_t WS_CDEC = 14 * MiB;
constexpr size_t WS_WIN = 16 * MiB;
constexpr size_t WS_WOUT = 25 * MiB;
constexpr size_t WS_WFGU = 29 * MiB;
constexpr size_t WS_WFD = 40 * MiB;
constexpr size_t WS_WMGU = 46 * MiB;
constexpr size_t WS_WMD = 102 * MiB;
constexpr size_t WS_H8 = 130 * MiB;
constexpr size_t WS_H = 214 * MiB;
constexpr size_t WS_SCR = 279 * MiB;
constexpr size_t WS_PROJ = WS_SCR;
#define OB(a_) ((unsigned char*)(a_).out)
constexpr size_t DO_STATES = 0;
constexpr size_t DO_HPREV = 32 * MiB;
constexpr size_t DO_BCA = 64 * MiB;
constexpr size_t DO_XDT = 96 * MiB;
constexpr size_t DO_DELTA = 0;
constexpr size_t DO_ACTM = 0;
constexpr size_t WS_XB = WS_SCR + 176 * MiB;
constexpr size_t WS_ACT = WS_SCR;
constexpr size_t WS_Y = WS_SCR;
constexpr size_t ACTM_BYTES = (size_t)CHB * 256 * EXPD;
constexpr size_t WS_PART = WS_SCR + 240 * MiB;
constexpr int TAIL_KS = 7, TAIL_ROWS = 8 * 256, TAIL_ROW0 = (NCHUNK - 1) * CHB * 256;
constexpr size_t WS_END = WS_PART + 28 * MiB;
static_assert(WS_END <= 571 * MiB, "ws");

constexpr int LDS_BYTES = 163840;
constexpr int MISC_OFF = 163840 - 256;
constexpr int GIDX_OFF = 131072 + 1024, GIDX_MAXU = 15;

#define GAS __attribute__((address_space(1)))
#define LAS __attribute__((address_space(3)))
typedef unsigned short bf16;
typedef float f32x4 __attribute__((ext_vector_type(4)));
typedef float f32x2 __attribute__((ext_vector_type(2)));
typedef unsigned u32x4 __attribute__((ext_vector_type(4)));
typedef unsigned u32x2 __attribute__((ext_vector_type(2)));
typedef short bf16x8 __attribute__((ext_vector_type(8)));
#define LDS_WAIT() asm volatile("s_waitcnt lgkmcnt(0)" ::: "memory")

__device__ __forceinline__ unsigned f2bf(float f) { unsigned u = __float_as_uint(f); return (u + 0x7fffu + ((u >> 16) & 1u)) >> 16; }
__device__ __forceinline__ unsigned cvt_pk_bf16(float lo, float hi) { unsigned r; asm volatile("v_cvt_pk_bf16_f32 %0, %1, %2" : "=v"(r) : "v"(lo), "v"(hi)); return r; }
__device__ __forceinline__ unsigned pk2(float lo, float hi) { return cvt_pk_bf16(lo, hi); }
__device__ __forceinline__ float bflo(unsigned w) { return __uint_as_float(w << 16); }
__device__ __forceinline__ float bfhi(unsigned w) { return __uint_as_float(w & 0xffff0000u); }
__device__ __forceinline__ float bf2f(bf16 b) { return __uint_as_float((unsigned)b << 16); }
__device__ __forceinline__ u32x2 pack4(f32x4 v) { u32x2 r; r.x = pk2(v.x, v.y); r.y = pk2(v.z, v.w); return r; }
__device__ __forceinline__ float silu_f(float v) { return v / (1.0f + __expf(-v)); }
__device__ __forceinline__ float silu_fast(float v) { return v * __builtin_amdgcn_rcpf(1.0f + __expf(-v)); }
__device__ __forceinline__ int lane_id() { int l; asm volatile("v_mbcnt_lo_u32_b32 %0, -1, 0\n\tv_mbcnt_hi_u32_b32 %0, -1, %0" : "=v"(l)); return l; }
__device__ __forceinline__ int opaque_tid(int wv) { int t = wv * 64 + lane_id(); asm volatile("" : "+v"(t)); return t; }
__device__ __forceinline__ float sx(float v, int o, int lane) { return __int_as_float(__builtin_amdgcn_ds_bpermute((lane ^ o) << 2, __float_as_int(v))); }
__device__ __forceinline__ float sfrom(float v, int src) { return __int_as_float(__builtin_amdgcn_ds_bpermute(src << 2, __float_as_int(v))); }
template <int CTRL> __device__ __forceinline__ float dpp_f(float v) { return __int_as_float(__builtin_amdgcn_update_dpp(0, __float_as_int(v), CTRL, 0xF, 0xF, true)); }
__device__ __forceinline__ float wave_sum(float v, int lane) {
    (void)lane;
    v += dpp_f<0xB1>(v); v += dpp_f<0x4E>(v); v += dpp_f<0x141>(v); v += dpp_f<0x140>(v);
    const int iv = __float_as_int(v);
    return (__int_as_float(__builtin_amdgcn_readlane(iv, 0)) + __int_as_float(__builtin_amdgcn_readlane(iv, 16))) + (__int_as_float(__builtin_amdgcn_readlane(iv, 32)) + __int_as_float(__builtin_amdgcn_readlane(iv, 48)));
}

__device__ const float INVF[32] = {1.0f, 0.7498942613601685f, 0.5623413324356079f, 0.4216965138912201f, 0.3162277638912201f, 0.23713737726211548f, 0.17782793939113617f, 0.133352130651474f, 0.10000000149011612f, 0.07498941570520401f, 0.05623413249850273f, 0.04216965287923813f, 0.03162277489900589f, 0.023713737726211548f, 0.017782794311642647f, 0.01333521492779255f, 0.009999999776482582f, 0.007498941849917173f, 0.005623413249850273f, 0.0042169648222625256f, 0.003162277629598975f, 0.00237137358635664f, 0.0017782794311642647f, 0.0013335214462131262f, 0.0010000000474974513f, 0.0007498942431993783f, 0.000562341301701963f, 0.0004216965171508491f, 0.0003162277571391314f, 0.00023713737027719617f, 0.00017782794020604342f, 0.0001333521504420787f};

#define XB_TMO      128
#define XB_XCNT(j)  (256  + 64 * (j))
#define XB_XSUB(j)  (1280 + 64 * (j))
#define XB_XGEN(j)  (2304 + 64 * (j))
#define XB_TOP      3328
#define XB_TOPGEN   3392
#define XCD_BAR_WORDS 3456
#define XB_SPIN_CAP (1u << 18)
__device__ __forceinline__ unsigned xb_ld(unsigned* p)              { return __hip_atomic_load(p, __ATOMIC_RELAXED, __HIP_MEMORY_SCOPE_AGENT); }
__device__ __forceinline__ unsigned xb_add(unsigned* p, unsigned v) { return __hip_atomic_fetch_add(p, v, __ATOMIC_RELAXED, __HIP_MEMORY_SCOPE_AGENT); }
__device__ __forceinline__ unsigned xb_xcc_id() { return (unsigned)__builtin_amdgcn_s_getreg((3 << 11) | 20) & 0xFu; }
#define XB_SPIN(cond, bar) do { unsigned _sp = 0; while (cond) { __builtin_amdgcn_s_sleep(1); \
    if ((++_sp & 255u) == 0u) { if (xb_ld(&(bar)[XB_TMO])) break; if (_sp > XB_SPIN_CAP) { atomicAdd(&(bar)[XB_TMO], 1u); break; } } } } while (0)
struct XcdBarrier { unsigned* bar; unsigned x; volatile LAS unsigned* st; int wv; };
__device__ __forceinline__ XcdBarrier xcd_barrier_post(unsigned* bar, volatile LAS unsigned* st, int wv) {
    XcdBarrier b; b.bar = bar; b.x = xb_xcc_id(); b.st = st; b.wv = wv;
    if (wv == 0 && lane_id() == 0) (void)xb_add(&bar[XB_XCNT(b.x)], 1u);
    return b;
}
__device__ __forceinline__ void xcd_barrier_complete(unsigned* bar, unsigned x, unsigned& nloc, unsigned& nx) {
    const unsigned G = gridDim.x * gridDim.y * gridDim.z;
    unsigned sum, cnt, mine, sp = 0u;
    for (;;) {
        sum = 0u; cnt = 0u; mine = 0u;
#pragma unroll
        for (unsigned j = 0; j < 16; ++j) { const unsigned c = xb_ld(&bar[XB_XCNT(j)]); sum += c; cnt += (c > 0u) ? 1u : 0u; mine = (j == x) ? c : mine; }
        if (sum == G) break;
        __builtin_amdgcn_s_sleep(1);
        if ((++sp & 255u) == 0u) { if (xb_ld(&bar[XB_TMO])) break; if (sp > XB_SPIN_CAP) { atomicAdd(&bar[XB_TMO], 1u); break; } }
    }
    nloc = mine > 0u ? mine : 1u; nx = cnt > 0u ? cnt : 1u;
}
__device__ __forceinline__ void xcd_barrier_leader(const XcdBarrier& b) {
    if (lane_id() == 0) {
        unsigned* bar = b.bar;
        asm volatile("" : "+s"(bar));
        __builtin_amdgcn_s_waitcnt(0);
        unsigned nloc = b.st[0], nx = b.st[1];
        if (nloc == 0u) { xcd_barrier_complete(bar, b.x, nloc, nx); b.st[0] = nloc; b.st[1] = nx; }
        const unsigned old = xb_add(&bar[XB_XSUB(b.x)], 1u);
        const unsigned gen = old / nloc;
        if (old + 1u == (gen + 1u) * nloc) {
            __builtin_amdgcn_fence(__ATOMIC_RELEASE, "agent");
            asm volatile("s_waitcnt vmcnt(0)" ::: "memory");
            const unsigned og = xb_add(&bar[XB_TOP], 1u);
            const unsigned tg = og / nx;
            if (og + 1u == (tg + 1u) * nx) {
#pragma unroll
                for (unsigned j = 0; j < 16; ++j) (void)xb_add(&bar[XB_XGEN(j)], 1u);
            } else XB_SPIN(xb_ld(&bar[XB_XGEN(b.x)]) == gen, bar);
            __builtin_amdgcn_fence(__ATOMIC_ACQUIRE, "agent");
            asm volatile("s_waitcnt vmcnt(0)" ::: "memory");
        } else {
            XB_SPIN(xb_ld(&bar[XB_XGEN(b.x)]) == gen, bar);
            __builtin_amdgcn_fence(__ATOMIC_ACQUIRE, "agent");
            asm volatile("s_waitcnt vmcnt(0)" ::: "memory");
        }
    }
}
__device__ __forceinline__ void xcd_barrier(const XcdBarrier& b) {
    asm volatile("s_waitcnt vmcnt(0)" ::: "memory");
    __syncthreads();
    if (b.wv == 0) xcd_barrier_leader(b);
    __syncthreads();
}

#define XCD_BARRIER_BG(b_, BG_STMT) do { \
    asm volatile("s_waitcnt vmcnt(0)" ::: "memory"); __syncthreads(); \
    if ((b_).wv == 0) xcd_barrier_leader(b_); else { BG_STMT; } \
    __syncthreads(); } while (0)

struct GemmProb {
    const void* A; int lda;
    const void* Bt; size_t bstride;
    const int* row_idx;
    const int* pad_end;
    int row0, nrows;
    int a_row_sub;
    int nN;
    int K;
    int dry;
    int wgm;
    int sclW, sclA;
    int ksplit;
};
__device__ __forceinline__ u32x4 pack8(f32x4 a, f32x4 b) { u32x4 w; w.x = cvt_pk_bf16(a.x, a.y); w.y = cvt_pk_bf16(a.z, a.w); w.z = cvt_pk_bf16(b.x, b.y); w.w = cvt_pk_bf16(b.z, b.w); return w; }
struct EpiStore { bf16* O; int ldc;
    __device__ __forceinline__ void row8(int row, int pn, int c8, f32x4 lo0, f32x4 lo1, f32x4 hi0, f32x4 hi1) const {
        bf16* p = O + (size_t)row * ldc + pn * 256 + c8; *(u32x4*)p = pack8(lo0, lo1); *(u32x4*)(p + 128) = pack8(hi0, hi1); } };
struct EpiResid { bf16* X; const float* gate;
    struct Ctx { f32x4 g0, g1, g2, g3; };
    __device__ __forceinline__ Ctx begin(int row0, int pn, int c8) const { const float* gp = gate + (size_t)(row0 / SEQ) * 6144 + pn * 256 + c8;
        Ctx c; c.g0 = *(const f32x4*)gp; c.g1 = *(const f32x4*)(gp + 4); c.g2 = *(const f32x4*)(gp + 128); c.g3 = *(const f32x4*)(gp + 132); return c; }
    __device__ __forceinline__ void row8(const Ctx& c, int row, int pn, int c8, f32x4 lo0, f32x4 lo1, f32x4 hi0, f32x4 hi1) const {
        bf16* p = X + (size_t)row * D + pn * 256 + c8; const u32x4 x0 = *(const u32x4*)p, x1 = *(const u32x4*)(p + 128);
        lo0 = c.g0 * lo0 + (f32x4){bflo(x0.x), bfhi(x0.x), bflo(x0.y), bfhi(x0.y)}; lo1 = c.g1 * lo1 + (f32x4){bflo(x0.z), bfhi(x0.z), bflo(x0.w), bfhi(x0.w)};
        hi0 = c.g2 * hi0 + (f32x4){bflo(x1.x), bfhi(x1.x), bflo(x1.y), bfhi(x1.y)}; hi1 = c.g3 * hi1 + (f32x4){bflo(x1.z), bfhi(x1.z), bflo(x1.w), bfhi(x1.w)};
        *(u32x4*)p = pack8(lo0, lo1); *(u32x4*)(p + 128) = pack8(hi0, hi1); } };
template <class E> struct epi_has_ctx { static constexpr bool value = false; };
template <> struct epi_has_ctx<EpiResid> { static constexpr bool value = true; };
struct EpiSplit { bf16* O; int ldc; int nN; size_t part_stride; int row_sub;
    __device__ __forceinline__ void row8(int row, int pnp, int c8, f32x4 lo0, f32x4 lo1, f32x4 hi0, f32x4 hi1) const {
        const int ks = pnp / nN, pn = pnp - ks * nN;
        bf16* p = O + (size_t)ks * part_stride + (size_t)(row - row_sub) * ldc + pn * 256 + c8; *(u32x4*)p = pack8(lo0, lo1); *(u32x4*)(p + 128) = pack8(hi0, hi1); } };
__device__ __forceinline__ float clamp448(float v) { return __builtin_amdgcn_fmed3f(v, -448.0f, 448.0f); }
__device__ __forceinline__ unsigned pk4_fp8(float a, float b, float c, float d) { int p = 0; p = __builtin_amdgcn_cvt_pk_fp8_f32(clamp448(a), clamp448(b), p, false); p = __builtin_amdgcn_cvt_pk_fp8_f32(clamp448(c), clamp448(d), p, true); return (unsigned)p; }
constexpr float W8_SCALE = 64.0f, ACT8_SCALE = 8.0f;
constexpr int E8_ONE = 0x7f7f7f7f, E8_W = 0x79797979, E8_ACT = 0x7c7c7c7c;
__device__ __forceinline__ f32x2 silu_mul2(f32x2 g, f32x2 u, float s_inv) {
    const f32x2 t = g * (-1.44269504f); f32x2 e; e.x = __builtin_amdgcn_exp2f(t.x); e.y = __builtin_amdgcn_exp2f(t.y);
    const f32x2 d = e * s_inv + s_inv; f32x2 r; r.x = __builtin_amdgcn_rcpf(d.x); r.y = __builtin_amdgcn_rcpf(d.y);
    return (g * u) * r;
}
struct EpiGU8 { unsigned char* O; int ldc; int row_sub;
    __device__ __forceinline__ void row8(int row, int pn, int c8, f32x4 lo0, f32x4 lo1, f32x4 hi0, f32x4 hi1) const {
        const float si = 1.0f / ACT8_SCALE;
        const f32x2 a = silu_mul2(__builtin_shufflevector(lo0, lo0, 0, 1), __builtin_shufflevector(hi0, hi0, 0, 1), si), b = silu_mul2(__builtin_shufflevector(lo0, lo0, 2, 3), __builtin_shufflevector(hi0, hi0, 2, 3), si);
        const f32x2 c = silu_mul2(__builtin_shufflevector(lo1, lo1, 0, 1), __builtin_shufflevector(hi1, hi1, 0, 1), si), d = silu_mul2(__builtin_shufflevector(lo1, lo1, 2, 3), __builtin_shufflevector(hi1, hi1, 2, 3), si);
        u32x2 w; w.x = pk4_fp8(a.x, a.y, b.x, b.y); w.y = pk4_fp8(c.x, c.y, d.x, d.y);
        *(u32x2*)(O + (size_t)(row - row_sub) * ldc + pn * 128 + c8) = w; } };
struct EpiGU { bf16* O; int ldc; int row_sub;
    __device__ __forceinline__ void row8(int row, int pn, int c8, f32x4 lo0, f32x4 lo1, f32x4 hi0, f32x4 hi1) const {
        const f32x2 a = silu_mul2(__builtin_shufflevector(lo0, lo0, 0, 1), __builtin_shufflevector(hi0, hi0, 0, 1), 1.0f), b = silu_mul2(__builtin_shufflevector(lo0, lo0, 2, 3), __builtin_shufflevector(hi0, hi0, 2, 3), 1.0f);
        const f32x2 c = silu_mul2(__builtin_shufflevector(lo1, lo1, 0, 1), __builtin_shufflevector(hi1, hi1, 0, 1), 1.0f), d = silu_mul2(__builtin_shufflevector(lo1, lo1, 2, 3), __builtin_shufflevector(hi1, hi1, 2, 3), 1.0f);
        u32x4 w; w.x = cvt_pk_bf16(a.x, a.y); w.y = cvt_pk_bf16(b.x, b.y); w.z = cvt_pk_bf16(c.x, c.y); w.w = cvt_pk_bf16(d.x, d.y);
        *(u32x4*)(O + (size_t)(row - row_sub) * ldc + pn * 128 + c8) = w; } };

constexpr int BM = 256, BK = 64, HALF = 128, HTB = HALF * BK * 2, NXCD = 8, WGM = 2;
__device__ __forceinline__ int lds_byte(int r, int c) { const int st = (r >> 4) * 2 + (c >> 5), rr = r & 15, cc = c & 31, ob = rr * 64 + cc * 2; return st * 1024 + (ob ^ (((ob >> 9) & 1) << 5)); }
__device__ __forceinline__ int perm32(int rho) { const int n = rho >> 4, i = rho & 15; return 8 * (i >> 2) + 4 * n + (i & 3); }
__device__ __forceinline__ void stage_rc(int b, int& R, int& C) { const int st = b / 1024, sb = b % 1024, swz = sb ^ (((sb >> 9) & 1) << 5); R = (st >> 1) * 16 + swz / 64; C = (st & 1) * 32 + (swz % 64) / 2; }
struct FUnit { int pm, pn; };
struct FOrder {
    int nM, nN, nwg, G, c, wgm;
    __device__ __forceinline__ void init(int nM_, int nN_, int G_, int c_, int wgm_) { nM = nM_; nN = nN_; nwg = nM * nN; G = G_; c = c_; wgm = wgm_; }
    __device__ __forceinline__ bool next(int i, FUnit& u) const {
        const long L = (long)i * G + c; if (L >= nwg) return false;
        int wgid = (int)L; { const int q = nwg / NXCD, r = nwg % NXCD, xcd = wgid % NXCD, off = wgid / NXCD; wgid = (xcd < r ? xcd * (q + 1) : r * (q + 1) + (xcd - r) * q) + off; }
        const int nig = wgm * nN, gid = wgid / nig, fm = gid * wgm, gsz = (nM - fm) < wgm ? (nM - fm) : wgm;
        u.pm = fm + ((wgid % nig) % gsz); u.pn = (wgid % nig) / gsz; return true;
    }
};

typedef int v8i __attribute__((ext_vector_type(8)));
typedef int i32x4 __attribute__((ext_vector_type(4)));
__device__ __forceinline__ v8i cat8(bf16x8 a, bf16x8 b) { const u32x4 x = __builtin_bit_cast(u32x4, a), y = __builtin_bit_cast(u32x4, b); v8i r = {(int)x.x, (int)x.y, (int)x.z, (int)x.w, (int)y.x, (int)y.y, (int)y.z, (int)y.w}; return r; }
template <bool F8> struct Frag { bf16x8 h[2]; };
template <> struct Frag<true> { v8i v; };
template <class Epi, bool GATHER, bool FP8>
__device__ __forceinline__ void gemm_fast(LAS unsigned char* lds, const GemmProb& g, const Epi& E, int wv) {
    const int tid = opaque_tid(wv), wid = __builtin_amdgcn_readfirstlane(tid >> 6), lane = tid & 63, wr = wid >> 2, wc = wid & 3, fr = lane & 15, fq = lane >> 4;
    constexpr int ESZ = FP8 ? 1 : 2;
    const int K = g.K * ESZ, klen = K / g.ksplit, nt = (g.dry == 2) ? 2 : klen / (BK * 2), lda = g.lda * ESZ;
    FOrder S; S.init(g.nrows / BM, g.nN * g.ksplit, (int)gridDim.x, (int)blockIdx.x, g.wgm);
    int Rr[2], Cc[2]; unsigned voffB[2];
#pragma unroll
    for (int i = 0; i < 2; ++i) { stage_rc(tid * 16 + i * 8192, Rr[i], Cc[i]); const int Rb = (Rr[i] & ~31) + perm32(Rr[i] & 31); voffB[i] = (unsigned)(Rb * K + Cc[i] * 2); }
    const size_t kstep = (size_t)(BK * 2);
    const size_t hstepB = (size_t)HALF * K;
    const unsigned ldsw = (unsigned)wid * 1024u;
    const int aoff = lds_byte(wr * 64 + fr, fq * 8), boff = lds_byte(wc * 32 + fr, fq * 8);
#define G_SA(b, h) (((b) * 2 + (h)) * HTB)
#define G_SB(b, h) ((4 + (b) * 2 + (h)) * HTB)
#define G_STAGE(bufoff, gbase, voff) do { _Pragma("unroll") for (int _i = 0; _i < 2; ++_i) \
        __builtin_amdgcn_global_load_lds((const unsigned*)((const char*)(gbase) + (voff)[_i]), (LAS unsigned*)(lds + (bufoff) + ldsw + _i * 8192), 16, 0, 0); } while (0)
#define G_LD8(p_) __builtin_shufflevector(*(const LAS i32x4*)(p_), *(const LAS i32x4*)((p_) + 1024), 0, 1, 2, 3, 4, 5, 6, 7)
#define G_LDF(dst, p_) do { if constexpr (FP8) { (dst).v = G_LD8(p_); } else { (dst).h[0] = *(const LAS bf16x8*)(p_); (dst).h[1] = *(const LAS bf16x8*)((p_) + 1024); } } while (0)
#define G_LDA(dst, b, h) do { if (g.dry == 4) break; _Pragma("unroll") for (int m = 0; m < 4; ++m) G_LDF(dst[m], lds + G_SA(b, h) + aoff + m * 2048); } while (0)
#define G_LDB(dst, b, h) do { if (g.dry == 4) break; _Pragma("unroll") for (int n = 0; n < 2; ++n) G_LDF(dst[n], lds + G_SB(b, h) + boff + n * 2048); } while (0)
#define G_MMA(ai, bj, At, Bt) do { if (g.dry == 3) break; __builtin_amdgcn_s_setprio(1); \
        if constexpr (FP8) { _Pragma("unroll") for (int m = 0; m < 4; ++m) _Pragma("unroll") for (int n = 0; n < 2; ++n) \
            asm volatile("v_mfma_scale_f32_16x16x128_f8f6f4 %0, %1, %2, %0, %3, %4 op_sel_hi:[0,0,0]" : "+v"(acc[ai][bj][m][n]) : "v"(Bt[n].v), "v"(At[m].v), "v"(sW_), "v"(sA_)); } \
        else { _Pragma("unroll") for (int m = 0; m < 4; ++m) _Pragma("unroll") for (int n = 0; n < 2; ++n) _Pragma("unroll") for (int k = 0; k < 2; ++k) \
            acc[ai][bj][m][n] = __builtin_amdgcn_mfma_f32_16x16x32_bf16(Bt[n].h[k], At[m].h[k], acc[ai][bj][m][n], 0, 0, 0); } \
        __builtin_amdgcn_s_setprio(0); } while (0)
#define G_WAIT_V(n) asm volatile("s_waitcnt vmcnt(" #n ")" ::: "memory")
#define G_WAIT_L(n) asm volatile("s_waitcnt lgkmcnt(" #n ")" ::: "memory")
#define G_BAR do { if (g.dry != 5) __builtin_amdgcn_s_barrier(); } while (0)
#define G_SCHED __builtin_amdgcn_sched_barrier(0)
    LAS int* GIDX = (LAS int*)(lds + GIDX_OFF);
#define G_AOFF(dst, u, ui_) do { const int _lr = g.row0 + (u).pm * BM; _Pragma("unroll") for (int _h = 0; _h < 2; ++_h) _Pragma("unroll") for (int _i = 0; _i < 2; ++_i) { \
        const int _ar = GATHER ? GIDX[(ui_) * 256 + _h * HALF + Rr[_i]] : (_lr + _h * HALF + Rr[_i] - g.a_row_sub); dst[_h][_i] = (unsigned)(_ar * lda + Cc[_i] * 2 + ((u).pn / g.nN) * klen); } } while (0)
    int pe0 = 0x7fffffff, pe1 = 0x7fffffff, pe2 = 0x7fffffff, pe3 = 0x7fffffff, pe4 = 0x7fffffff, pe5 = 0x7fffffff, pe6 = 0x7fffffff;
    if (g.pad_end) { pe0 = g.pad_end[0]; pe1 = g.pad_end[1]; pe2 = g.pad_end[2]; pe3 = g.pad_end[3]; pe4 = g.pad_end[4]; pe5 = g.pad_end[5]; pe6 = g.pad_end[6]; }
#define G_BPTR(u, out) do { const int _r = g.row0 + (u).pm * BM; const int _e = (_r >= pe0) + (_r >= pe1) + (_r >= pe2) + (_r >= pe3) + (_r >= pe4) + (_r >= pe5) + (_r >= pe6); \
        const int _ks = (u).pn / g.nN, _pn = (u).pn - _ks * g.nN; out = (const char*)g.Bt + (size_t)_e * g.bstride * ESZ + (size_t)_pn * BM * K + (size_t)_ks * klen; } while (0)
    if (GATHER) {
        FUnit u_;
        for (int i_ = 0; i_ < GIDX_MAXU && S.next(i_, u_); ++i_) if (tid < 256) GIDX[i_ * 256 + tid] = g.row_idx[g.row0 + u_.pm * BM + tid];
        __syncthreads();
    }
    const int sW_ = g.sclW, sA_ = g.sclA; (void)sW_; (void)sA_;
    FUnit cur, nxt; int ui = 0;
    if (!S.next(0, cur)) return;
    f32x4 acc[2][2][4][2];
#pragma unroll
    for (int a_ = 0; a_ < 2; ++a_)
#pragma unroll
        for (int b_ = 0; b_ < 2; ++b_)
#pragma unroll
            for (int m = 0; m < 4; ++m)
#pragma unroll
                for (int n = 0; n < 2; ++n) acc[a_][b_][m][n] = (f32x4){0.f, 0.f, 0.f, 0.f};
    Frag<FP8> At[4], B0[2], B1[2];
    unsigned cOff[2][2], nOff[2][2];
    const char* cB; const char* nB;
    const char* gA = (const char*)g.A;
    G_AOFF(cOff, cur, 0); G_BPTR(cur, cB);
#if GEMM_SP2
    G_STAGE(G_SB(0, 0), cB, voffB); G_STAGE(G_SB(0, 1), cB + hstepB, voffB); G_STAGE(G_SA(0, 0), gA, cOff[0]); G_STAGE(G_SA(0, 1), gA, cOff[1]);
    if (wr == 1) G_BAR;
    G_WAIT_V(2); G_BAR;
    G_STAGE(G_SB(1, 0), cB + kstep, voffB); G_STAGE(G_SA(1, 0), gA + kstep, cOff[0]); G_STAGE(G_SB(1, 1), cB + hstepB + kstep, voffB);
    G_WAIT_V(6); G_BAR;
#else
    G_STAGE(G_SB(0, 0), cB, voffB); G_STAGE(G_SA(0, 0), gA, cOff[0]); G_STAGE(G_SB(0, 1), cB + hstepB, voffB); G_STAGE(G_SA(0, 1), gA, cOff[1]);
    if (wr == 1) G_BAR;
    G_WAIT_V(4); G_BAR;
    G_STAGE(G_SB(1, 0), cB + kstep, voffB); G_STAGE(G_SA(1, 0), gA + kstep, cOff[0]); G_STAGE(G_SB(1, 1), cB + hstepB + kstep, voffB);
    G_WAIT_V(6); G_BAR;
#endif
    for (;;) {
        const bool has_next = S.next(ui + 1, nxt);
        if (has_next) { G_AOFF(nOff, nxt, ui + 1); G_BPTR(nxt, nB); }
        else {
#pragma unroll
            for (int h_ = 0; h_ < 2; ++h_)
#pragma unroll
                for (int i_ = 0; i_ < 2; ++i_) nOff[h_][i_] = cOff[h_][i_];
            nB = cB; }
        for (int t = 0; t < nt; t += 2) {
            const bool last = (t == nt - 2);
            const char* a1 = gA + (size_t)(t + 1) * kstep;
            const char* a2 = last ? gA : gA + (size_t)(t + 2) * kstep; const char* b2 = last ? nB : cB + (size_t)(t + 2) * kstep;
            const char* a3 = a2 + kstep; const char* b3 = b2 + kstep;
            unsigned o2[2][2];
#pragma unroll
            for (int h_ = 0; h_ < 2; ++h_)
#pragma unroll
                for (int i_ = 0; i_ < 2; ++i_) o2[h_][i_] = last ? nOff[h_][i_] : cOff[h_][i_];
#if GEMM_SP2
            G_LDB(B0, 0, 0); G_LDB(B1, 0, 1); G_SCHED; G_LDA(At, 0, 0); G_STAGE(G_SA(1, 1), a1, cOff[1]);
            G_WAIT_V(8); G_WAIT_L(0); G_BAR; G_MMA(0, 0, At, B0); G_MMA(0, 1, At, B1); G_BAR; G_SCHED;
            G_LDA(At, 0, 1); G_STAGE(G_SB(0, 0), b2, voffB); G_STAGE(G_SB(0, 1), b2 + hstepB, voffB); G_STAGE(G_SA(0, 0), a2, o2[0]);
            G_WAIT_V(8); G_WAIT_L(0); G_BAR; G_MMA(1, 0, At, B0); G_MMA(1, 1, At, B1); G_BAR; G_SCHED;
            G_LDB(B0, 1, 0); G_LDB(B1, 1, 1); G_SCHED; G_LDA(At, 1, 0); G_STAGE(G_SA(0, 1), a2, o2[1]);
            G_WAIT_V(8); G_WAIT_L(0); G_BAR; G_MMA(0, 0, At, B0); G_MMA(0, 1, At, B1); G_BAR; G_SCHED;
            G_LDA(At, 1, 1); G_STAGE(G_SB(1, 0), b3, voffB); G_STAGE(G_SB(1, 1), b3 + hstepB, voffB); G_STAGE(G_SA(1, 0), a3, o2[0]);
            G_WAIT_V(8); G_WAIT_L(0); G_BAR; G_MMA(1, 0, At, B0); G_MMA(1, 1, At, B1); G_BAR; G_SCHED;
#else
            G_LDB(B0, 0, 0); G_SCHED; G_LDA(At, 0, 0); G_STAGE(G_SA(1, 1), a1, cOff[1]);
            G_WAIT_L(8); G_BAR; G_WAIT_L(0); G_MMA(0, 0, At, B0); G_BAR; G_SCHED;
            G_LDB(B1, 0, 1); G_STAGE(G_SB(0, 0), b2, voffB);
            G_BAR; G_WAIT_L(0); G_MMA(0, 1, At, B1); G_BAR;
            G_LDA(At, 0, 1); G_STAGE(G_SA(0, 0), a2, o2[0]);
            G_BAR; G_WAIT_L(0); G_MMA(1, 0, At, B0); G_BAR; G_SCHED;
            G_STAGE(G_SB(0, 1), b2 + hstepB, voffB);
            G_WAIT_V(6); G_BAR; G_MMA(1, 1, At, B1); G_BAR;
            G_LDB(B0, 1, 0); G_SCHED; G_LDA(At, 1, 0); G_STAGE(G_SA(0, 1), a2, o2[1]);
            G_WAIT_L(8); G_BAR; G_WAIT_L(0); G_MMA(0, 0, At, B0); G_BAR; G_SCHED;
            G_LDB(B1, 1, 1); G_STAGE(G_SB(1, 0), b3, voffB);
            G_BAR; G_WAIT_L(0); G_MMA(0, 1, At, B1); G_BAR;
            G_LDA(At, 1, 1); G_STAGE(G_SA(1, 0), a3, o2[0]);
            G_BAR; G_WAIT_L(0); G_MMA(1, 0, At, B0); G_BAR; G_SCHED;
            G_STAGE(G_SB(1, 1), b3 + hstepB, voffB);
            G_WAIT_V(6); G_BAR; G_MMA(1, 1, At, B1); G_BAR;
#endif
        }
        if (wr == 0) G_BAR;
        {
            const int rowb = g.row0 + cur.pm * BM + wr * 64 + fr, c8 = wc * 32 + 8 * fq;
            if (!g.dry) {
              if constexpr (epi_has_ctx<Epi>::value) {
                const auto ctx = E.begin(g.row0 + cur.pm * BM, cur.pn, c8);
#pragma unroll
                for (int ai = 0; ai < 2; ++ai)
#pragma unroll
                    for (int m = 0; m < 4; ++m) E.row8(ctx, rowb + ai * HALF + m * 16, cur.pn, c8, acc[ai][0][m][0], acc[ai][0][m][1], acc[ai][1][m][0], acc[ai][1][m][1]);
              } else {
#pragma unroll
                for (int ai = 0; ai < 2; ++ai)
#pragma unroll
                    for (int m = 0; m < 4; ++m) E.row8(rowb + ai * HALF + m * 16, cur.pn, c8, acc[ai][0][m][0], acc[ai][0][m][1], acc[ai][1][m][0], acc[ai][1][m][1]);
              }
            }
        }
        if (!has_next) break;
#pragma unroll
        for (int a_ = 0; a_ < 2; ++a_)
#pragma unroll
            for (int b_ = 0; b_ < 2; ++b_)
#pragma unroll
                for (int m = 0; m < 4; ++m)
#pragma unroll
                    for (int n = 0; n < 2; ++n) acc[a_][b_][m][n] = (f32x4){0.f, 0.f, 0.f, 0.f};
        cur = nxt; cB = nB; ++ui;
#pragma unroll
        for (int h_ = 0; h_ < 2; ++h_)
#pragma unroll
            for (int i_ = 0; i_ < 2; ++i_) cOff[h_][i_] = nOff[h_][i_];
        if (wr == 1) G_BAR;
    }
    G_WAIT_V(0);
    G_BAR;
#undef G_SA
#undef G_SB
#undef G_STAGE
#undef G_LD8
#undef G_LDF
#undef G_LDA
#undef G_LDB
#undef G_MMA
#undef G_WAIT_V
#undef G_WAIT_L
#undef G_BAR
#undef G_SCHED
#undef G_AOFF
#undef G_BPTR
}

template <class Epi, bool GATHER, bool FP8 = false>
__device__ __forceinline__ void gemm_run(LAS unsigned char* lds, const GemmProb& g, const Epi& E, int wv) {
    gemm_fast<Epi, GATHER, FP8>(lds, g, E, wv);
}

__device__ __forceinline__ void tr_item(const float* W, int ldw, int K, int k0, int n0, bf16* WT, int dst_row0, LAS float* scr, int lane) {
    f32x4 v[8];
#pragma unroll
    for (int j = 0; j < 8; ++j) v[j] = *(const f32x4*)(W + (size_t)(k0 + 8 * j + (lane >> 3)) * ldw + n0 + 4 * (lane & 7));
#pragma unroll
    for (int j = 0; j < 8; ++j) { LAS float* d = scr + (8 * j + (lane >> 3)) * 33 + 4 * (lane & 7); d[0] = v[j].x; d[1] = v[j].y; d[2] = v[j].z; d[3] = v[j].w; }
    LDS_WAIT(); asm volatile("" ::: "memory");
    const int c = lane & 7;
#pragma unroll
    for (int j = 0; j < 4; ++j) { const int n = (lane >> 3) + 8 * j; const LAS float* sp = scr + (8 * c) * 33 + n;
        u32x4 o; o.x = pk2(sp[0 * 33], sp[1 * 33]); o.y = pk2(sp[2 * 33], sp[3 * 33]); o.z = pk2(sp[4 * 33], sp[5 * 33]); o.w = pk2(sp[6 * 33], sp[7 * 33]);
        *(u32x4*)(WT + (size_t)(dst_row0 + n) * K + k0 + 8 * c) = o; }
    LDS_WAIT(); asm volatile("" ::: "memory");
}
__device__ __forceinline__ void tr_item8(const float* W, int ldw, int K, int k0, int n0, unsigned char* WT, int dst_row0, LAS float* scr, int lane) {
    f32x4 v[8];
#pragma unroll
    for (int j = 0; j < 8; ++j) v[j] = *(const f32x4*)(W + (size_t)(k0 + 8 * j + (lane >> 3)) * ldw + n0 + 4 * (lane & 7));
#pragma unroll
    for (int j = 0; j < 8; ++j) { LAS float* d = scr + (8 * j + (lane >> 3)) * 33 + 4 * (lane & 7); d[0] = v[j].x; d[1] = v[j].y; d[2] = v[j].z; d[3] = v[j].w; }
    LDS_WAIT(); asm volatile("" ::: "memory");
    const int c = lane & 7;
#pragma unroll
    for (int j = 0; j < 4; ++j) { const int n = (lane >> 3) + 8 * j; const LAS float* sp = scr + (8 * c) * 33 + n;
        u32x2 o; o.x = pk4_fp8(W8_SCALE * sp[0 * 33], W8_SCALE * sp[1 * 33], W8_SCALE * sp[2 * 33], W8_SCALE * sp[3 * 33]); o.y = pk4_fp8(W8_SCALE * sp[4 * 33], W8_SCALE * sp[5 * 33], W8_SCALE * sp[6 * 33], W8_SCALE * sp[7 * 33]);
        *(u32x2*)(WT + (size_t)(dst_row0 + n) * K + k0 + 8 * c) = o; }
    LDS_WAIT(); asm volatile("" ::: "memory");
}
__device__ __forceinline__ int gu_row(int n0) { return (n0 >> 7) * 256 + (n0 & 127); }

__device__ __forceinline__ void sincos_acc(float angf, float& s, float& c) {
    const double a = (double)angf;
    const double n = rint(a * 0.15915494309189535);
    double r = fma(-n, 6.283185307179586, a); r = fma(-n, 2.4492935982947064e-16, r);
    const double r2 = r * r;
    double ts = 1.0, tc = 1.0, ss = 1.0, cs = 1.0;
#pragma unroll
    for (int k = 1; k <= 14; ++k) { tc *= r2 * (-1.0 / (double)((2 * k - 1) * (2 * k))); cs += tc; ts *= r2 * (-1.0 / (double)((2 * k) * (2 * k + 1))); ss += ts; }
    s = (float)(r * ss); c = (float)cs;
}

struct Args { const float* in[24]; float* out; unsigned char* ws; int ph_lo, ph_hi; };

constexpr int TR_I_IN = 16 * 72, TR_I_OUT = 16 * 32, TR_I_FG = 16 * 88, TR_I_FD = 44 * 32, TR_I_MG = 16 * 112, TR_I_MD = 56 * 32;
constexpr int TR_NITEMS = 2 * TR_I_IN + 2 * TR_I_OUT + 2 * TR_I_FG + TR_I_FD + 16 * TR_I_MG + 8 * TR_I_MD;
constexpr int TR_DEFER = 7168;
constexpr int TR_PRO_END = TR_NITEMS - 2 * TR_DEFER;
constexpr int TR_BG0 = 2 * TR_I_IN + 2 * TR_I_OUT + 2 * TR_I_FG + TR_I_FD;
constexpr int TR_BG_PER = 256 * 7, TR_BG_NBAR = (TR_PRO_END - TR_BG0) / TR_BG_PER;
static_assert(TR_BG0 + TR_BG_NBAR * TR_BG_PER == TR_PRO_END && TR_BG_NBAR == 16, "background conversion split");
__device__ __forceinline__ void tr_range(LAS unsigned char* lds, const Args& a, int wv, int it_lo, int it_hi, int rank, int nrank) {
    const int tid = opaque_tid(wv), lane = tid & 63, wave = tid >> 6; unsigned char* ws = a.ws;
    {
        LAS float* scr = (LAS float*)(lds + wave * 16384);
        const int gw = it_lo + rank, NGW = nrank;
        constexpr int I_IN = TR_I_IN, I_OUT = TR_I_OUT, I_FG = TR_I_FG, I_FD = TR_I_FD, I_MG = TR_I_MG, I_MD = TR_I_MD;
        struct TrIt { const float* W; unsigned char* dst; int ldw, K, k0, n0, row0, f8; };
        auto decode = [&](int it) -> TrIt { TrIt t; int r = it;
            if (r < 2 * I_IN) { const int l = r / I_IN; r %= I_IN; const int kb = r / 72, nb = r % 72; t = TrIt{a.in[7] + (size_t)l * 1024 * INW, ws + WS_WIN + (size_t)l * NPROJ * 1024 * 2, INW, 1024, kb * 64, nb * 32, nb * 32, 0}; return t; }
            r -= 2 * I_IN;
            if (r < 2 * I_OUT) { const int l = r / I_OUT; r %= I_OUT; const int kb = r / 32, nb = r % 32; t = TrIt{a.in[8] + (size_t)l * 1024 * 1024, ws + WS_WOUT + (size_t)l * 1024 * 1024 * 2, 1024, 1024, kb * 64, nb * 32, nb * 32, 0}; return t; }
            r -= 2 * I_OUT;
            if (r < 2 * I_FG) { const int up = r / I_FG; r %= I_FG; const int kb = r / 88, nb = r % 88; t = TrIt{a.in[16 + up], ws + WS_WFGU, FFN, 1024, kb * 64, nb * 32, gu_row(nb * 32) + up * 128, DENSE_GU_FP8}; return t; }
            r -= 2 * I_FG;
            if (r < I_FD) { const int kb = r / 32, nb = r % 32; t = TrIt{a.in[18], ws + WS_WFD, 1024, FFN, kb * 64, nb * 32, nb * 32, 0}; return t; }
            r -= I_FD;
            if (r < 16 * I_MG) { const int up = r / (8 * I_MG); r %= 8 * I_MG; const int e = r / I_MG; r %= I_MG; const int kb = r / 112, nb = r % 112;
                t = TrIt{a.in[20 + up] + (size_t)e * 1024 * EXPD, ws + WS_WMGU + (size_t)e * 7168 * 1024, EXPD, 1024, kb * 64, nb * 32, gu_row(nb * 32) + up * 128, 1}; return t; }
            r -= 16 * I_MG;
            { const int e = r / I_MD; r %= I_MD; const int kb = r / 32, nb = r % 32; t = TrIt{a.in[22] + (size_t)e * EXPD * 1024, ws + WS_WMD + (size_t)e * 1024 * EXPD, 1024, EXPD, kb * 64, nb * 32, nb * 32, 1}; return t; } };
        f32x4 v[8], vn[8];
        TrIt cur{}, nxt{};
        if (gw < it_hi) { cur = decode(gw);
#pragma unroll
            for (int j = 0; j < 8; ++j) v[j] = __builtin_nontemporal_load((const f32x4*)(cur.W + (size_t)(cur.k0 + 8 * j + (lane >> 3)) * cur.ldw + cur.n0 + 4 * (lane & 7))); }
        for (int it = gw; it < it_hi; it += NGW) {
            const bool more = it + NGW < it_hi;
            if (more) { nxt = decode(it + NGW);
#pragma unroll
                for (int j = 0; j < 8; ++j) vn[j] = __builtin_nontemporal_load((const f32x4*)(nxt.W + (size_t)(nxt.k0 + 8 * j + (lane >> 3)) * nxt.ldw + nxt.n0 + 4 * (lane & 7))); }
            asm volatile("" ::: "memory");
#pragma unroll
            for (int j = 0; j < 8; ++j) { LAS float* d = scr + (8 * j + (lane >> 3)) * 33 + 4 * (lane & 7); d[0] = v[j].x; d[1] = v[j].y; d[2] = v[j].z; d[3] = v[j].w; }
            LDS_WAIT(); asm volatile("" ::: "memory");
            const int c = lane & 7;
#pragma unroll
            for (int j = 0; j < 4; ++j) { const int n = (lane >> 3) + 8 * j; const LAS float* sp = scr + (8 * c) * 33 + n;
                if (cur.f8) { u32x2 o; o.x = pk4_fp8(W8_SCALE * sp[0 * 33], W8_SCALE * sp[1 * 33], W8_SCALE * sp[2 * 33], W8_SCALE * sp[3 * 33]); o.y = pk4_fp8(W8_SCALE * sp[4 * 33], W8_SCALE * sp[5 * 33], W8_SCALE * sp[6 * 33], W8_SCALE * sp[7 * 33]);
                    *(u32x2*)(cur.dst + (size_t)(cur.row0 + n) * cur.K + cur.k0 + 8 * c) = o; }
                else { u32x4 o; o.x = pk2(sp[0 * 33], sp[1 * 33]); o.y = pk2(sp[2 * 33], sp[3 * 33]); o.z = pk2(sp[4 * 33], sp[5 * 33]); o.w = pk2(sp[6 * 33], sp[7 * 33]);
                    *(u32x4*)(cur.dst + ((size_t)(cur.row0 + n) * cur.K + cur.k0 + 8 * c) * 2) = o; } }
            LDS_WAIT(); asm volatile("" ::: "memory");
            cur = nxt;
#pragma unroll
            for (int j = 0; j < 8; ++j) v[j] = vn[j];
        }
    }
}

__device__ __forceinline__ void prologue_phase(LAS unsigned char* lds, const Args& a, int wv) {
    const int tid = opaque_tid(wv), lane = tid & 63, wave = tid >> 6, G = gridDim.x;
    unsigned char* ws = a.ws;
    {
        LAS float* cact = (LAS float*)lds;
        LAS float* red = (LAS float*)(lds + 16384);
        const float* c = a.in[1];
        for (int i = tid; i < 4096; i += 512) cact[i] = silu_f(c[i]);
        __syncthreads();
        float* MOD = (float*)(ws + WS_MOD);
        for (int u = blockIdx.x; u < 192; u += G) {
            const int l = u / 96, j0 = (u % 96) * 64;
            const float* W = a.in[3] + (size_t)l * 1024 * 6144;
            const int col = tid & 63, kg = tid >> 6;
            float acc0 = 0.f, acc1 = 0.f, acc2 = 0.f, acc3 = 0.f;
#pragma unroll 1
            for (int k0 = kg * 128; k0 < kg * 128 + 128; k0 += 32) {
                float w[32];
#pragma unroll
                for (int q = 0; q < 32; ++q) w[q] = __builtin_nontemporal_load(W + (size_t)(k0 + q) * 6144 + j0 + col);
                asm volatile("" ::: "memory");
#pragma unroll
                for (int q = 0; q < 32; ++q) { const int k = k0 + q; acc0 += cact[k] * w[q]; acc1 += cact[1024 + k] * w[q]; acc2 += cact[2048 + k] * w[q]; acc3 += cact[3072 + k] * w[q]; } }
            red[(kg * 4 + 0) * 64 + col] = acc0; red[(kg * 4 + 1) * 64 + col] = acc1; red[(kg * 4 + 2) * 64 + col] = acc2; red[(kg * 4 + 3) * 64 + col] = acc3;
            __syncthreads();
            if (tid < 256) { const int b = tid >> 6, cc = tid & 63; float s = 0.f;
#pragma unroll
                for (int q = 0; q < 8; ++q) s += red[(q * 4 + b) * 64 + cc];
                MOD[(size_t)(l * 4 + b) * 6144 + j0 + cc] = s + a.in[4][l * 6144 + j0 + cc]; }
            __syncthreads();
        }
    }
    {
        const int* pos = (const int*)a.in[2];
        float* COS = (float*)(ws + WS_COS); float* SIN = (float*)(ws + WS_SIN);
        for (int e = blockIdx.x * 512 + tid; e < T * 32; e += G * 512) {
            const int tok = e >> 5, i = e & 31; const float ang = (float)pos[tok] * INVF[i];
            float s, c; sincos_acc(ang, s, c); COS[e] = c; SIN[e] = s; }
    }
    if (blockIdx.x == 0) { unsigned* hp = (unsigned*)((bf16*)(ws + WS_H) + (size_t)T * D); for (int i = tid; i < 256 * D / 2; i += 512) hp[i] = 0u;
                           unsigned* h8 = (unsigned*)(ws + WS_H8 + (size_t)T * D); for (int i = tid; i < 256 * D / 4; i += 512) h8[i] = 0u; }
    __syncthreads();
    tr_range(lds, a, wv, 0, (MK_MULTI || G != 256) ? TR_PRO_END : TR_BG0, blockIdx.x * 8 + wave, G * 8);
}

template <int MODE, bool DELTA, bool XBF, bool WRX = false>
__device__ __forceinline__ void norm_phase(LAS unsigned char* lds, const Args& a, int l, const void* Xin, const float* dgate, int wv) {
    const int tid = opaque_tid(wv), lane = tid & 63, wave = tid >> 6, G = gridDim.x;
    unsigned char* ws = a.ws;
    const int rpw = T / G, r0 = blockIdx.x * rpw, b = r0 / SEQ;
    const float* gain = a.in[MODE == 0 ? 5 : 6] + l * D;
    const float* modb = (const float*)(ws + WS_MOD) + (size_t)(l * 4 + b) * 6144 + (MODE == 0 ? 0 : 3 * 1024);
    bf16* H = (bf16*)(ws + WS_H); const bf16* DL = (const bf16*)(OB(a) + DO_DELTA);
    f32x4 gs[4], sh[4], gd[4];
#pragma unroll
    for (int j = 0; j < 4; ++j) { const int col = 4 * lane + 256 * j; const f32x4 g = *(const f32x4*)(gain + col), sc = *(const f32x4*)(modb + 1024 + col);
        gs[j] = g * (1.0f + sc); sh[j] = *(const f32x4*)(modb + col); gd[j] = DELTA ? *(const f32x4*)(dgate + b * 6144 + col) : (f32x4){0.f, 0.f, 0.f, 0.f}; }
    LAS f32x4* WA = (LAS f32x4*)lds;
    LAS f32x4* WB = (LAS f32x4*)(lds + 16384);
    if (MODE != 1) {
        const float* W8 = MODE == 0 ? a.in[7] + (size_t)l * 1024 * INW + NPROJ : a.in[19];
        const int ldw = MODE == 0 ? INW : 8;
        for (int idx = tid; idx < 1024; idx += 512) { const int je = idx >> 6, ln = idx & 63; const int k = 256 * (je >> 2) + 4 * ln + (je & 3);
            const float* wp = W8 + (size_t)k * ldw;
            WA[idx] = (f32x4){wp[0], wp[1], wp[2], wp[3]}; WB[idx] = (f32x4){wp[4], wp[5], wp[6], wp[7]}; }
        __syncthreads();
    }
    LAS int* wge = (LAS int*)(lds + 32768);
    f32x4 xn[2][4]; u32x2 xb[2][4]; u32x2 dn[2][4];
    bf16* XBo = (bf16*)(ws + WS_XB);
#define N_LOADROW(u_, row_) do { const f32x4* xr = (const f32x4*)((const float*)Xin + (size_t)(row_) * D) + lane; const u32x2* xq = (const u32x2*)((const bf16*)Xin + (size_t)(row_) * D) + lane; \
        const u32x2* dr = (const u32x2*)(DL + (size_t)(row_) * D) + lane; \
        _Pragma("unroll") for (int j = 0; j < 4; ++j) { if (XBF) xb[u_][j] = xq[64 * j]; else xn[u_][j] = __builtin_nontemporal_load(xr + 64 * j); if (DELTA) dn[u_][j] = dr[64 * j]; } } while (0)
#pragma unroll
    for (int u = 0; u < 2; ++u) N_LOADROW(u, r0 + wave + 8 * u);
#pragma unroll 1
    for (int i0 = wave; i0 < rpw; i0 += 16) {
        asm volatile("" ::: "memory");
        f32x4 vv[2][4];
#pragma unroll
        for (int u = 0; u < 2; ++u)
#pragma unroll
            for (int j = 0; j < 4; ++j) { vv[u][j] = XBF ? (f32x4){bflo(xb[u][j].x), bfhi(xb[u][j].x), bflo(xb[u][j].y), bfhi(xb[u][j].y)} : xn[u][j];
                if (DELTA) { const f32x4 dv = {bflo(dn[u][j].x), bfhi(dn[u][j].x), bflo(dn[u][j].y), bfhi(dn[u][j].y)}; vv[u][j] += gd[j] * dv; } }
        if (i0 + 16 < rpw) {
#pragma unroll
            for (int u = 0; u < 2; ++u) N_LOADROW(u, r0 + i0 + 16 + 8 * u); }
#undef N_LOADROW
#pragma unroll
      for (int u = 0; u < 2; ++u) {
        const int i = i0 + 8 * u, row = r0 + i;
        f32x4 v[4]; float ss = 0.f;
#pragma unroll
        for (int j = 0; j < 4; ++j) v[j] = vv[u][j];
        if (DELTA || WRX) { u32x2* xo = (u32x2*)(XBo + (size_t)row * D) + lane;
#pragma unroll
            for (int j = 0; j < 4; ++j) { u32x2 w; w.x = cvt_pk_bf16(v[j].x, v[j].y); w.y = cvt_pk_bf16(v[j].z, v[j].w); xo[64 * j] = w; } }
#pragma unroll
        for (int j = 0; j < 4; ++j) ss += (v[j].x * v[j].x + v[j].y * v[j].y) + (v[j].z * v[j].z + v[j].w * v[j].w);
        ss = wave_sum(ss, lane);
        const float rstd = 1.0f / sqrtf(ss * (1.0f / D) + EPS);
        u32x2* o8 = (u32x2*)(H + (size_t)row * D) + lane; unsigned* o4 = (unsigned*)(ws + WS_H8 + (size_t)row * D) + lane;
#pragma unroll
        for (int j = 0; j < 4; ++j) { v[j] = v[j] * rstd * gs[j] + sh[j];
            if (MODE == 2 || (MODE == 1 && DENSE_GU_FP8)) o4[64 * j] = pk4_fp8(v[j].x, v[j].y, v[j].z, v[j].w);
            else { u32x2 w; w.x = cvt_pk_bf16(v[j].x, v[j].y); w.y = cvt_pk_bf16(v[j].z, v[j].w); o8[64 * j] = w; } }
        if (MODE != 1) {
            float acc[8];
            { f32x4 a0 = {0.f, 0.f, 0.f, 0.f}, a1 = {0.f, 0.f, 0.f, 0.f};
#pragma unroll
              for (int j = 0; j < 4; ++j)
#pragma unroll
                for (int e = 0; e < 4; ++e) { const f32x4 wa = WA[(4 * j + e) * 64 + lane], wb = WB[(4 * j + e) * 64 + lane]; a0 += v[j][e] * wa; a1 += v[j][e] * wb; }
              acc[0] = a0.x; acc[1] = a0.y; acc[2] = a0.z; acc[3] = a0.w; acc[4] = a1.x; acc[5] = a1.y; acc[6] = a1.z; acc[7] = a1.w; }
#pragma unroll
            for (int o = 0; o < 8; ++o) acc[o] = wave_sum(acc[o], lane);
            if (MODE == 0) {
                float my = acc[0];
#pragma unroll
                for (int o = 1; o < 8; ++o) my = (lane == o) ? acc[o] : my;
                if (lane < 8) { const float xx = my + a.in[12][l * 8 + lane];
                    const float ex = __expf(-fabsf(xx)); const float l1p = (ex < 1e-3f) ? ex * (1.0f - 0.5f * ex) : __logf(1.0f + ex);
                    const float sp = fmaxf(xx, 0.f) + l1p;
                    ((float*)(ws + WS_DT))[(size_t)row * 8 + lane] = sp; }
            } else {
                int i0x = 0; float v0 = acc[0];
#pragma unroll
                for (int o = 1; o < 8; ++o) if (acc[o] > v0) { v0 = acc[o]; i0x = o; }
                int i1x = -1; float v1 = -3.0e38f;
#pragma unroll
                for (int o = 0; o < 8; ++o) if (o != i0x && acc[o] > v1) { v1 = acc[o]; i1x = o; }
                const float ee = expf(v1 - v0), g0 = 1.0f / (1.0f + ee), g1 = ee / (1.0f + ee);
                if (lane == 0) { ((int*)(ws + WS_TOKE))[row * 2] = i0x; ((int*)(ws + WS_TOKE))[row * 2 + 1] = i1x;
                    ((float*)(ws + WS_TOKG))[row * 2] = g0; ((float*)(ws + WS_TOKG))[row * 2 + 1] = g1;
                    wge[i * 2] = i0x; wge[i * 2 + 1] = i1x; }
            }
        }
      }
    }
    if (MODE == 2) {
        __syncthreads();
        const int na = rpw * 2;
        for (int aidx = tid; aidx < na; aidx += 512) { const int e = wge[aidx]; int rank = 0; for (int q = 0; q < aidx; ++q) rank += (wge[q] == e) ? 1 : 0;
            ((int*)(ws + WS_TOKD))[(size_t)r0 * 2 + aidx] = rank; }
        if (tid < 8) { int cnt = 0; for (int q = 0; q < na; ++q) cnt += (wge[q] == tid) ? 1 : 0; ((int*)(ws + WS_WGCNT))[blockIdx.x * 8 + tid] = cnt; }
        __syncthreads();
    }
}

__device__ __forceinline__ void route_phase(LAS unsigned char* lds, const Args& a, int wv) {
    const int tid = opaque_tid(wv), G = gridDim.x; unsigned char* ws = a.ws;
    const int rpw = T / G, r0 = blockIdx.x * rpw;
    LAS int* cnt = (LAS int*)lds;
    LAS int* tot = cnt + G * 8;
    LAS int* base = tot + 8;
    LAS int* ps = base + 8;
    LAS int* pe = ps + 8;
    const int* wgc = (const int*)(ws + WS_WGCNT);
    { const int lane = tid & 63, e = tid >> 6; int c4[4];
#pragma unroll
      for (int k = 0; k < 4; ++k) c4[k] = (4 * lane + k < G) ? wgc[(4 * lane + k) * 8 + e] : 0;
      asm volatile("" ::: "memory");
      const int mine = c4[0] + c4[1] + c4[2] + c4[3]; int inc = mine;
#pragma unroll
      for (int o = 1; o < 64; o <<= 1) { const int t = __builtin_amdgcn_ds_bpermute((lane - o) << 2, inc); if (lane >= o) inc += t; }
      if (lane == 63) tot[e] = inc;
      if (lane == ((int)blockIdx.x >> 2)) { int bs = inc - mine; const int kb = (int)blockIdx.x & 3; if (kb > 0) bs += c4[0]; if (kb > 1) bs += c4[1]; if (kb > 2) bs += c4[2]; base[e] = bs; } }
    __syncthreads();
    if (tid == 0) { int acc = 0; for (int e = 0; e < 8; ++e) { ps[e] = acc; acc += (tot[e] + 255) / 256 * 256; pe[e] = acc; } }
    __syncthreads();
    int* tokd = (int*)(ws + WS_TOKD); const int* toke = (const int*)(ws + WS_TOKE); int* rowtok = (int*)(ws + WS_ROWTOK);
    for (int aidx = tid; aidx < rpw * 2; aidx += 512) { const size_t gi = (size_t)r0 * 2 + aidx; const int e = toke[gi]; const int dest = ps[e] + base[e] + tokd[gi];
        tokd[gi] = dest; rowtok[dest] = r0 + (aidx >> 1); }
    if (blockIdx.x < 8) { const int e = blockIdx.x; for (int r = ps[e] + tot[e] + tid; r < pe[e]; r += 512) rowtok[r] = T; }
    if (blockIdx.x == 0 && tid < 8) { ((int*)(ws + WS_META))[tid] = pe[tid]; if (tid == 7) ((int*)(ws + WS_META))[8] = pe[7] / 256; }
}

__device__ __forceinline__ void final_phase(const Args& a, int wv) {
    const int tid = opaque_tid(wv), lane = tid & 63, wave = __builtin_amdgcn_readfirstlane(tid >> 6), G = gridDim.x; unsigned char* ws = a.ws;
    const float* gfin = a.in[23];
    const bf16* Y = (const bf16*)(ws + WS_Y);
    const int* tokd = (const int*)(ws + WS_TOKD); const float* tokg = (const float*)(ws + WS_TOKG);
    const int rpv = T / (G * 8);
    const int base = (blockIdx.x * 8 + wave) * rpv;
    int md0 = 0, md1 = 0; float mg0 = 0.f, mg1 = 0.f;
    if (lane < rpv) { md0 = tokd[(base + lane) * 2]; md1 = tokd[(base + lane) * 2 + 1]; mg0 = tokg[(base + lane) * 2]; mg1 = tokg[(base + lane) * 2 + 1]; }
    const int b = base / SEQ;
    const float* gf = (const float*)(ws + WS_MOD) + (size_t)(4 + b) * 6144 + 5 * 1024;
    f32x4 gfv[4], gfn[4];
#pragma unroll
    for (int j = 0; j < 4; ++j) { gfv[j] = *(const f32x4*)(gf + 4 * lane + 256 * j); gfn[j] = *(const f32x4*)(gfin + 4 * lane + 256 * j); }
    const bf16* PART = (const bf16*)(ws + WS_PART);
    u32x2 xn[4], y0n[4], y1n[4]; const bf16* XBi = (const bf16*)(ws + WS_XB);
    int cd0 = __builtin_amdgcn_readlane(md0, 0), cd1 = __builtin_amdgcn_readlane(md1, 0);
    { const u32x2* xr = (const u32x2*)(XBi + (size_t)base * D) + lane;
      const u32x2* p0 = (const u32x2*)(cd0 < TAIL_ROW0 ? Y + (size_t)cd0 * D : PART + (size_t)(cd0 - TAIL_ROW0) * D) + lane;
      const u32x2* p1 = (const u32x2*)(cd1 < TAIL_ROW0 ? Y + (size_t)cd1 * D : PART + (size_t)(cd1 - TAIL_ROW0) * D) + lane;
#pragma unroll
      for (int j = 0; j < 4; ++j) { xn[j] = __builtin_nontemporal_load(xr + 64 * j); y0n[j] = __builtin_nontemporal_load(p0 + 64 * j); y1n[j] = __builtin_nontemporal_load(p1 + 64 * j); } }
#pragma unroll 1
    for (int i = 0; i < rpv; ++i) {
        const int row = base + i;
        const float g0f = __int_as_float(__builtin_amdgcn_readlane(__float_as_int(mg0), i)), g1f = __int_as_float(__builtin_amdgcn_readlane(__float_as_int(mg1), i));
        f32x4 ya[4], yb[4];
#pragma unroll
        for (int j = 0; j < 4; ++j) { ya[j] = (f32x4){bflo(y0n[j].x), bfhi(y0n[j].x), bflo(y0n[j].y), bfhi(y0n[j].y)}; yb[j] = (f32x4){bflo(y1n[j].x), bfhi(y1n[j].x), bflo(y1n[j].y), bfhi(y1n[j].y)}; }
        if (cd0 >= TAIL_ROW0) { const u32x2* pp = (const u32x2*)(PART + (size_t)(cd0 - TAIL_ROW0) * D) + lane;
            for (int sp = 1; sp < TAIL_KS; ++sp)
#pragma unroll
                for (int j = 0; j < 4; ++j) { const u32x2 w = pp[(size_t)sp * TAIL_ROWS * D / 4 + 64 * j]; ya[j] += (f32x4){bflo(w.x), bfhi(w.x), bflo(w.y), bfhi(w.y)}; } }
        if (cd1 >= TAIL_ROW0) { const u32x2* pp = (const u32x2*)(PART + (size_t)(cd1 - TAIL_ROW0) * D) + lane;
            for (int sp = 1; sp < TAIL_KS; ++sp)
#pragma unroll
                for (int j = 0; j < 4; ++j) { const u32x2 w = pp[(size_t)sp * TAIL_ROWS * D / 4 + 64 * j]; yb[j] += (f32x4){bflo(w.x), bfhi(w.x), bflo(w.y), bfhi(w.y)}; } }
        f32x4 v[4]; float ss = 0.f;
#pragma unroll
        for (int j = 0; j < 4; ++j) { v[j] = (f32x4){bflo(xn[j].x), bfhi(xn[j].x), bflo(xn[j].y), bfhi(xn[j].y)} + gfv[j] * (g0f * ya[j] + g1f * yb[j]); ss += (v[j].x * v[j].x + v[j].y * v[j].y) + (v[j].z * v[j].z + v[j].w * v[j].w); }
        if (i + 1 < rpv) {
            cd0 = __builtin_amdgcn_readlane(md0, i + 1); cd1 = __builtin_amdgcn_readlane(md1, i + 1);
            const u32x2* xr = (const u32x2*)(XBi + (size_t)(row + 1) * D) + lane;
            const u32x2* p0 = (const u32x2*)(cd0 < TAIL_ROW0 ? Y + (size_t)cd0 * D : PART + (size_t)(cd0 - TAIL_ROW0) * D) + lane;
            const u32x2* p1 = (const u32x2*)(cd1 < TAIL_ROW0 ? Y + (size_t)cd1 * D : PART + (size_t)(cd1 - TAIL_ROW0) * D) + lane;
#pragma unroll
            for (int j = 0; j < 4; ++j) { xn[j] = __builtin_nontemporal_load(xr + 64 * j); y0n[j] = __builtin_nontemporal_load(p0 + 64 * j); y1n[j] = __builtin_nontemporal_load(p1 + 64 * j); } }
        ss = wave_sum(ss, lane);
        const float rstd = 1.0f / sqrtf(ss * (1.0f / D) + EPS);
        f32x4* xo = (f32x4*)(a.out + (size_t)row * D) + lane;
#pragma unroll
        for (int j = 0; j < 4; ++j) __builtin_nontemporal_store(v[j] * rstd * gfn[j], xo + 64 * j);
    }
}

__device__ __forceinline__ void attn_naive(const Args& a, int l) {
    unsigned char* ws = a.ws; const bf16* P = (const bf16*)(ws + WS_PROJ); bf16* MIX = (bf16*)(ws + WS_H);
    const float* COS = (const float*)(ws + WS_COS); const float* SIN = (const float*)(ws + WS_SIN);
    for (int idx = blockIdx.x * 512 + threadIdx.x; idx < T * 8; idx += gridDim.x * 512) {
        const int tok = idx >> 3, h = idx & 7, kvh = h >> 2, b = tok / SEQ, s = tok % SEQ;
        float q[64];
        { const u32x4* qp = (const u32x4*)(P + (size_t)tok * NPROJ + C_Q + h * 64);
#pragma unroll
          for (int c = 0; c < 4; ++c) { const u32x4 w0 = qp[c], w1 = qp[c + 4];
              const float x1[8] = {bflo(w0.x), bfhi(w0.x), bflo(w0.y), bfhi(w0.y), bflo(w0.z), bfhi(w0.z), bflo(w0.w), bfhi(w0.w)};
              const float x2[8] = {bflo(w1.x), bfhi(w1.x), bflo(w1.y), bfhi(w1.y), bflo(w1.z), bfhi(w1.z), bflo(w1.w), bfhi(w1.w)};
#pragma unroll
              for (int i = 0; i < 8; ++i) { const float cs = COS[tok * 32 + c * 8 + i], sn = SIN[tok * 32 + c * 8 + i];
                  q[c * 8 + i] = x1[i] * cs - x2[i] * sn; q[32 + c * 8 + i] = x2[i] * cs + x1[i] * sn; } } }
        float m = a.in[9][l * 8 + h], lsum = 1.0f; float acc[64];
#pragma unroll
        for (int i = 0; i < 64; ++i) acc[i] = 0.f;
        const int jlo = s - 127 > 0 ? s - 127 : 0;
        for (int j = jlo; j <= s; ++j) {
            const int tk = b * SEQ + j;
            const u32x4* kp = (const u32x4*)(P + (size_t)tk * NPROJ + C_K + kvh * 64);
            float sc = 0.f;
#pragma unroll
            for (int c = 0; c < 4; ++c) { const u32x4 w0 = kp[c], w1 = kp[c + 4];
                const float x1[8] = {bflo(w0.x), bfhi(w0.x), bflo(w0.y), bfhi(w0.y), bflo(w0.z), bfhi(w0.z), bflo(w0.w), bfhi(w0.w)};
                const float x2[8] = {bflo(w1.x), bfhi(w1.x), bflo(w1.y), bfhi(w1.y), bflo(w1.z), bfhi(w1.z), bflo(w1.w), bfhi(w1.w)};
#pragma unroll
                for (int i = 0; i < 8; ++i) { const float cs = COS[tk * 32 + c * 8 + i], sn = SIN[tk * 32 + c * 8 + i];
                    sc += q[c * 8 + i] * (x1[i] * cs - x2[i] * sn) + q[32 + c * 8 + i] * (x2[i] * cs + x1[i] * sn); } }
            sc *= 0.125f;
            const float mn = fmaxf(m, sc), alpha = __expf(m - mn), p = __expf(sc - mn);
            lsum = lsum * alpha + p; m = mn;
            const u32x4* vp = (const u32x4*)(P + (size_t)tk * NPROJ + C_V + kvh * 64);
#pragma unroll
            for (int c = 0; c < 8; ++c) { const u32x4 w = vp[c];
                acc[c * 8 + 0] = acc[c * 8 + 0] * alpha + p * bflo(w.x); acc[c * 8 + 1] = acc[c * 8 + 1] * alpha + p * bfhi(w.x);
                acc[c * 8 + 2] = acc[c * 8 + 2] * alpha + p * bflo(w.y); acc[c * 8 + 3] = acc[c * 8 + 3] * alpha + p * bfhi(w.y);
                acc[c * 8 + 4] = acc[c * 8 + 4] * alpha + p * bflo(w.z); acc[c * 8 + 5] = acc[c * 8 + 5] * alpha + p * bfhi(w.z);
                acc[c * 8 + 6] = acc[c * 8 + 6] * alpha + p * bflo(w.w); acc[c * 8 + 7] = acc[c * 8 + 7] * alpha + p * bfhi(w.w); }
        }
        const float inv = 1.0f / lsum;
        u32x4* op = (u32x4*)(MIX + (size_t)tok * D + h * 64);
#pragma unroll
        for (int c = 0; c < 8; ++c) { u32x4 o; o.x = pk2(acc[c * 8] * inv, acc[c * 8 + 1] * inv); o.y = pk2(acc[c * 8 + 2] * inv, acc[c * 8 + 3] * inv);
            o.z = pk2(acc[c * 8 + 4] * inv, acc[c * 8 + 5] * inv); o.w = pk2(acc[c * 8 + 6] * inv, acc[c * 8 + 7] * inv); op[c] = o; }
    }
}

__device__ __forceinline__ void ssd_naive_scan(const Args& a, int l) {
    unsigned char* ws = a.ws; const bf16* P = (const bf16*)(ws + WS_PROJ); const float* DT = (const float*)(ws + WS_DT);
    float* YG = (float*)(OB(a) + DO_STATES);
    const int idx = blockIdx.x * 512 + threadIdx.x;
    if (idx >= 32768) return;
    const int nc = idx & 15, p = (idx >> 4) & 63, h = (idx >> 10) & 7, b = idx >> 13, g = h >> 2;
    const float* cw = a.in[10] + (size_t)l * 4 * 1024; const float* cb = a.in[11] + l * 1024;
    const int chx = h * 64 + p, chB = 512 + g * 128 + nc * 8, chC = 768 + g * 128 + nc * 8;
    float wx[4], wB[4][8], wC[4][8], bx, bB[8], bC[8];
#pragma unroll
    for (int k = 0; k < 4; ++k) { wx[k] = cw[k * 1024 + chx];
#pragma unroll
        for (int i = 0; i < 8; ++i) { wB[k][i] = cw[k * 1024 + chB + i]; wC[k][i] = cw[k * 1024 + chC + i]; } }
    bx = cb[chx];
#pragma unroll
    for (int i = 0; i < 8; ++i) { bB[i] = cb[chB + i]; bC[i] = cb[chC + i]; }
    float hx[3] = {0.f, 0.f, 0.f}, hB[3][8], hC[3][8], st[8];
#pragma unroll
    for (int k = 0; k < 3; ++k)
#pragma unroll
        for (int i = 0; i < 8; ++i) { hB[k][i] = 0.f; hC[k][i] = 0.f; }
#pragma unroll
    for (int i = 0; i < 8; ++i) st[i] = 0.f;
    const float aneg = -expf(a.in[13][l * 8 + h]), dsk = a.in[14][l * 8 + h];
    for (int t = 0; t < SEQ; ++t) {
        const size_t tok = (size_t)b * SEQ + t; const bf16* pr = P + tok * NPROJ;
        const float xc = bf2f(pr[C_XS + chx]);
        const u32x4 bw = *(const u32x4*)(pr + C_XS + chB), cwv = *(const u32x4*)(pr + C_XS + chC);
        const float Bc[8] = {bflo(bw.x), bfhi(bw.x), bflo(bw.y), bfhi(bw.y), bflo(bw.z), bfhi(bw.z), bflo(bw.w), bfhi(bw.w)};
        const float Cc[8] = {bflo(cwv.x), bfhi(cwv.x), bflo(cwv.y), bfhi(cwv.y), bflo(cwv.z), bfhi(cwv.z), bflo(cwv.w), bfhi(cwv.w)};
        const float xs = silu_f(wx[0] * hx[0] + wx[1] * hx[1] + wx[2] * hx[2] + wx[3] * xc + bx);
        hx[0] = hx[1]; hx[1] = hx[2]; hx[2] = xc;
        const float dt = DT[tok * 8 + h], dA = __expf(dt * aneg), xd = dt * xs;
        float yp = 0.f;
#pragma unroll
        for (int i = 0; i < 8; ++i) {
            const float Bn = silu_f(wB[0][i] * hB[0][i] + wB[1][i] * hB[1][i] + wB[2][i] * hB[2][i] + wB[3][i] * Bc[i] + bB[i]);
            const float Cn = silu_f(wC[0][i] * hC[0][i] + wC[1][i] * hC[1][i] + wC[2][i] * hC[2][i] + wC[3][i] * Cc[i] + bC[i]);
            hB[0][i] = hB[1][i]; hB[1][i] = hB[2][i]; hB[2][i] = Bc[i]; hC[0][i] = hC[1][i]; hC[1][i] = hC[2][i]; hC[2][i] = Cc[i];
            st[i] = dA * st[i] + xd * Bn; yp += Cn * st[i];
        }
        yp += __shfl_xor(yp, 1); yp += __shfl_xor(yp, 2); yp += __shfl_xor(yp, 4); yp += __shfl_xor(yp, 8);
        if (nc == 0) { const float y = yp + dsk * xs; const float z = bf2f(pr[C_Z + chx]); YG[tok * 512 + chx] = y * silu_f(z); }
    }
}
__device__ __forceinline__ void ssd_naive_norm(const Args& a, int l) {
    unsigned char* ws = a.ws; const float* YG = (const float*)(OB(a) + DO_STATES); bf16* MIX = (bf16*)(ws + WS_H);
    const int lane = threadIdx.x & 63, wave = threadIdx.x >> 6; const float* gn = a.in[15] + l * 512;
    for (int row = blockIdx.x * 8 + wave; row < T; row += gridDim.x * 8) {
        const f32x4 v0 = *(const f32x4*)(YG + (size_t)row * 512 + lane * 8), v1 = *(const f32x4*)(YG + (size_t)row * 512 + lane * 8 + 4);
        float ss = (v0.x * v0.x + v0.y * v0.y) + (v0.z * v0.z + v0.w * v0.w) + (v1.x * v1.x + v1.y * v1.y) + (v1.z * v1.z + v1.w * v1.w);
#pragma unroll
        for (int o = 1; o < 32; o <<= 1) ss += __shfl_xor(ss, o);
        const float rstd = 1.0f / sqrtf(ss * (1.0f / 256.f) + EPS);
        const f32x4 g0 = *(const f32x4*)(gn + lane * 8), g1 = *(const f32x4*)(gn + lane * 8 + 4);
        u32x4 o; const f32x4 r0 = v0 * rstd * g0, r1 = v1 * rstd * g1; o.x = pk2(r0.x, r0.y); o.y = pk2(r0.z, r0.w); o.z = pk2(r1.x, r1.y); o.w = pk2(r1.z, r1.w);
        *(u32x4*)(MIX + (size_t)row * D + 512 + lane * 8) = o;
    }
}


__device__ __forceinline__ bf16x8 mk_frag(u32x2 lo, u32x2 hi) { u32x4 t = {lo.x, lo.y, hi.x, hi.y}; return __builtin_bit_cast(bf16x8, t); }
constexpr int AT_KS = 0, AT_VT = 36864;
__device__ __forceinline__ void rope8(const u32x4 w0, const u32x4 w1, const float* cs, const float* sn, float scale, u32x4& o0, u32x4& o1) {
    const f32x4 c0 = *(const f32x4*)cs, c1 = *(const f32x4*)(cs + 4), s0 = *(const f32x4*)sn, s1 = *(const f32x4*)(sn + 4);
    const float x1[8] = {bflo(w0.x), bfhi(w0.x), bflo(w0.y), bfhi(w0.y), bflo(w0.z), bfhi(w0.z), bflo(w0.w), bfhi(w0.w)};
    const float x2[8] = {bflo(w1.x), bfhi(w1.x), bflo(w1.y), bfhi(w1.y), bflo(w1.z), bfhi(w1.z), bflo(w1.w), bfhi(w1.w)};
    const float cc[8] = {c0.x, c0.y, c0.z, c0.w, c1.x, c1.y, c1.z, c1.w}, ss[8] = {s0.x, s0.y, s0.z, s0.w, s1.x, s1.y, s1.z, s1.w};
    float y1[8], y2[8];
#pragma unroll
    for (int i = 0; i < 8; ++i) { y1[i] = (x1[i] * cc[i] - x2[i] * ss[i]) * scale; y2[i] = (x2[i] * cc[i] + x1[i] * ss[i]) * scale; }
    o0.x = pk2(y1[0], y1[1]); o0.y = pk2(y1[2], y1[3]); o0.z = pk2(y1[4], y1[5]); o0.w = pk2(y1[6], y1[7]);
    o1.x = pk2(y2[0], y2[1]); o1.y = pk2(y2[2], y2[3]); o1.z = pk2(y2[4], y2[5]); o1.w = pk2(y2[6], y2[7]);
}
__device__ __forceinline__ void attn_phase(LAS unsigned char* lds, const Args& a, int l, int wv) {
    const int tid = opaque_tid(wv), lane = tid & 63, wid = __builtin_amdgcn_readfirstlane(tid >> 6), fr = lane & 15, fq = lane >> 4;
    unsigned char* ws = a.ws; const bf16* P = (const bf16*)(ws + WS_PROJ); bf16* MIX = (bf16*)(ws + WS_H);
    const float* COS = (const float*)(ws + WS_COS); const float* SIN = (const float*)(ws + WS_SIN);
    for (int i = tid; i < 64 * 8; i += 512) *(LAS unsigned*)(lds + AT_VT + (i >> 3) * 544 + 512 + (i & 7) * 4) = 0u;
    for (int u = blockIdx.x; u < 512; u += gridDim.x) {
        const int kvh = u & 1, blk = (u >> 1) & 63, b = u >> 7;
        const int tok0 = b * SEQ + blk * 128;
        __syncthreads();
        for (int task = tid; task < 1024; task += 512) {
            const int key = task >> 2, c = task & 3; const int kt = tok0 - 128 + key; const bool valid = (blk > 0) || key >= 128;
            u32x4 o0 = {0u, 0u, 0u, 0u}, o1 = {0u, 0u, 0u, 0u};
            if (valid) { const bf16* kp = P + (size_t)kt * NPROJ + C_K + kvh * 64; const u32x4 w0 = *(const u32x4*)(kp + 8 * c), w1 = *(const u32x4*)(kp + 32 + 8 * c);
                rope8(w0, w1, COS + (size_t)kt * 32 + 8 * c, SIN + (size_t)kt * 32 + 8 * c, 1.0f, o0, o1); }
            *(LAS u32x4*)(lds + AT_KS + key * 144 + c * 16) = o0; *(LAS u32x4*)(lds + AT_KS + key * 144 + 64 + c * 16) = o1;
        }
        if (tid >= 256) {
            const int t = tid - 256, seg = t & 31, c = t >> 5, key0 = seg * 8; u32x4 w[8];
#pragma unroll
            for (int r = 0; r < 8; ++r) { const int key = key0 + r, kt = tok0 - 128 + key; w[r] = (u32x4){0u, 0u, 0u, 0u};
                if ((blk > 0) || key >= 128) w[r] = *(const u32x4*)(P + (size_t)kt * NPROJ + C_V + kvh * 64 + 8 * c); }
#pragma unroll
            for (int i = 0; i < 8; ++i) { u32x4 o;
                if (i & 1) { o.x = (w[0][i >> 1] >> 16) | (w[1][i >> 1] & 0xffff0000u); o.y = (w[2][i >> 1] >> 16) | (w[3][i >> 1] & 0xffff0000u); o.z = (w[4][i >> 1] >> 16) | (w[5][i >> 1] & 0xffff0000u); o.w = (w[6][i >> 1] >> 16) | (w[7][i >> 1] & 0xffff0000u); }
                else { o.x = (w[0][i >> 1] & 0xffffu) | (w[1][i >> 1] << 16); o.y = (w[2][i >> 1] & 0xffffu) | (w[3][i >> 1] << 16); o.z = (w[4][i >> 1] & 0xffffu) | (w[5][i >> 1] << 16); o.w = (w[6][i >> 1] & 0xffffu) | (w[7][i >> 1] << 16); }
                *(LAS u32x4*)(lds + AT_VT + (8 * c + i) * 544 + key0 * 2) = o; }
        }
        __syncthreads();
        const int g = wid >> 1, h = kvh * 4 + g; const float sink = a.in[9][l * 8 + h];
#pragma unroll 1
        for (int qt = 0; qt < 4; ++qt) {
            const int i0 = (wid & 1) * 64 + qt * 16, kt0 = i0 >> 4; const int qtok = tok0 + i0 + fr;
            bf16x8 q0, q1;
            { const bf16* qp = P + (size_t)qtok * NPROJ + C_Q + h * 64; const u32x4 w0 = *(const u32x4*)(qp + 8 * fq), w1 = *(const u32x4*)(qp + 32 + 8 * fq);
              u32x4 o0, o1; rope8(w0, w1, COS + (size_t)qtok * 32 + 8 * fq, SIN + (size_t)qtok * 32 + 8 * fq, 0.125f, o0, o1);
              q0 = __builtin_bit_cast(bf16x8, o0); q1 = __builtin_bit_cast(bf16x8, o1); }
            f32x4 sacc[9];
#pragma unroll
            for (int kt = 0; kt < 9; ++kt) { const int krow = 16 * (kt0 + kt) + fr;
                const bf16x8 k0 = *(const LAS bf16x8*)(lds + AT_KS + krow * 144 + fq * 16), k1 = *(const LAS bf16x8*)(lds + AT_KS + krow * 144 + 64 + fq * 16);
                f32x4 acc = {0.f, 0.f, 0.f, 0.f};
                acc = __builtin_amdgcn_mfma_f32_16x16x32_bf16(k0, q0, acc, 0, 0, 0); acc = __builtin_amdgcn_mfma_f32_16x16x32_bf16(k1, q1, acc, 0, 0, 0); sacc[kt] = acc; }
            const int qi = i0 + fr; float mx = sink;
#pragma unroll
            for (int kt = 0; kt < 9; ++kt)
#pragma unroll
                for (int r = 0; r < 4; ++r) { const int kk = 16 * (kt0 + kt) + 4 * fq + r; const bool vis = (kk >= qi + 1) && (kk <= qi + 128) && (blk > 0 || kk >= 128);
                    const float sv = vis ? sacc[kt][r] : -__builtin_inff(); sacc[kt][r] = sv; mx = fmaxf(mx, sv); }
            mx = fmaxf(mx, sx(mx, 16, lane)); mx = fmaxf(mx, sx(mx, 32, lane));
            float sum = 0.f;
#pragma unroll
            for (int kt = 0; kt < 9; ++kt)
#pragma unroll
                for (int r = 0; r < 4; ++r) { const float pv = __expf(sacc[kt][r] - mx); sacc[kt][r] = pv; sum += pv; }
            sum += sx(sum, 16, lane); sum += sx(sum, 32, lane);
            const float inv = 1.0f / (sum + __expf(sink - mx));
            bf16x8 pf[5];
#pragma unroll
            for (int s2 = 0; s2 < 5; ++s2) { const f32x4 pa = sacc[2 * s2] * inv; f32x4 pb = {0.f, 0.f, 0.f, 0.f}; if (2 * s2 + 1 < 9) pb = sacc[(2 * s2 + 1) < 9 ? (2 * s2 + 1) : 8] * inv;
                pf[s2] = mk_frag(pack4(pa), pack4(pb)); }
            f32x4 o[4];
#pragma unroll
            for (int d = 0; d < 4; ++d) o[d] = (f32x4){0.f, 0.f, 0.f, 0.f};
#pragma unroll
            for (int s2 = 0; s2 < 5; ++s2)
#pragma unroll
                for (int d = 0; d < 4; ++d) { const LAS unsigned char* vb = lds + AT_VT + (16 * d + fr) * 544 + (16 * (kt0 + 2 * s2) + 4 * fq) * 2;
                    const bf16x8 vf = mk_frag(*(const LAS u32x2*)vb, *(const LAS u32x2*)(vb + 32));
                    o[d] = __builtin_amdgcn_mfma_f32_16x16x32_bf16(vf, pf[s2], o[d], 0, 0, 0); }
#pragma unroll
            for (int d = 0; d < 4; ++d) *(u32x2*)(MIX + (size_t)qtok * D + h * 64 + 16 * d + 4 * fq) = pack4(o[d]);
        }
    }
}

struct Conv8W { float w[4][8]; float b[8]; };
__device__ __forceinline__ void conv8_load(Conv8W& W, const float* cw, const float* cb, int ch) {
#pragma unroll
    for (int k = 0; k < 4; ++k) { const f32x4 x = *(const f32x4*)(cw + k * 1024 + ch), y = *(const f32x4*)(cw + k * 1024 + ch + 4);
        W.w[k][0] = x.x; W.w[k][1] = x.y; W.w[k][2] = x.z; W.w[k][3] = x.w; W.w[k][4] = y.x; W.w[k][5] = y.y; W.w[k][6] = y.z; W.w[k][7] = y.w; }
    const f32x4 x = *(const f32x4*)(cb + ch), y = *(const f32x4*)(cb + ch + 4);
    W.b[0] = x.x; W.b[1] = x.y; W.b[2] = x.z; W.b[3] = x.w; W.b[4] = y.x; W.b[5] = y.y; W.b[6] = y.z; W.b[7] = y.w;
}
__device__ __forceinline__ void conv8_apply(const Conv8W& W, const bf16* P, size_t tok, int spos, int col, float (&out)[8]) {
    u32x4 r[4];
#pragma unroll
    for (int k = 0; k < 4; ++k) { const int d = 3 - k; r[k] = (u32x4){0u, 0u, 0u, 0u}; if (spos >= d) r[k] = *(const u32x4*)(P + (tok - d) * NPROJ + col); }
#pragma unroll
    for (int i = 0; i < 8; ++i) out[i] = W.b[i];
#pragma unroll
    for (int k = 0; k < 4; ++k) { const float x[8] = {bflo(r[k].x), bfhi(r[k].x), bflo(r[k].y), bfhi(r[k].y), bflo(r[k].z), bfhi(r[k].z), bflo(r[k].w), bfhi(r[k].w)};
#pragma unroll
        for (int i = 0; i < 8; ++i) out[i] += W.w[k][i] * x[i]; }
#pragma unroll
    for (int i = 0; i < 8; ++i) out[i] = silu_f(out[i]);
}
__device__ __forceinline__ void conv_seg8(const bf16* P, size_t tok0, int cidx, int l0, int col, const float* cw, const float* cb, int ch, float (&out)[8][8]) {
    u32x4 x[11];
#pragma unroll
    for (int j = 0; j < 11; ++j) { const int lr = l0 - 3 + j; x[j] = (u32x4){0u, 0u, 0u, 0u}; if (cidx * 128 + lr >= 0) x[j] = *(const u32x4*)(P + (size_t)((long)tok0 + lr) * NPROJ + col); }
    Conv8W W; conv8_load(W, cw, cb, ch);
#pragma unroll
    for (int i = 0; i < 8; ++i) { float xf[11];
#pragma unroll
        for (int j = 0; j < 11; ++j) xf[j] = (i & 1) ? bfhi(x[j][i >> 1]) : bflo(x[j][i >> 1]);
#pragma unroll
        for (int r = 0; r < 8; ++r) out[r][i] = silu_fast(W.b[i] + W.w[0][i] * xf[r] + W.w[1][i] * xf[r + 1] + W.w[2][i] * xf[r + 2] + W.w[3][i] * xf[r + 3]); }
}
constexpr int SROW = 272;
__device__ __forceinline__ u32x4 pk8(const float (&o)[8]) { u32x4 w; w.x = cvt_pk_bf16(o[0], o[1]); w.y = cvt_pk_bf16(o[2], o[3]); w.z = cvt_pk_bf16(o[4], o[5]); w.w = cvt_pk_bf16(o[6], o[7]); return w; }
constexpr int S1_XD = 0, S1_BT = 69632, S1_DT = 104448, S1_ACS = 106496, S1_WD = 108544;
__device__ __forceinline__ void ssd1_phase(LAS unsigned char* lds, const Args& a, int l, int wv) {
    const int tid = opaque_tid(wv), lane = tid & 63, wid = __builtin_amdgcn_readfirstlane(tid >> 6), fr = lane & 15, fq = lane >> 4;
    unsigned char* ws = a.ws; const bf16* P = (const bf16*)(ws + WS_PROJ); const float* DT = (const float*)(ws + WS_DT);
    float* ACS = (float*)(ws + WS_ACS); float* CDEC = (float*)(ws + WS_CDEC); bf16* STATES = (bf16*)(OB(a) + DO_STATES);
    bf16* BCA = (bf16*)(OB(a) + DO_BCA); bf16* XDT = (bf16*)(OB(a) + DO_XDT);
    const float* cw = a.in[10] + (size_t)l * 4096; const float* cb = a.in[11] + l * 1024;
    LAS float* dts = (LAS float*)(lds + S1_DT); LAS float* acs = (LAS float*)(lds + S1_ACS); LAS float* wdec = (LAS float*)(lds + S1_WD);
    for (int u = blockIdx.x; u < 512; u += gridDim.x) {
        const int g = u & 1, c = (u >> 1) & 63, b = u >> 7; const size_t tok0 = (size_t)b * SEQ + c * 128;
        __syncthreads();
        if (wid < 4) {
            const int h = 4 * g + wid; const float aneg = -expf(a.in[13][l * 8 + h]); const int t0 = 2 * lane;
            const float dt0 = DT[(tok0 + t0) * 8 + h], dt1 = DT[(tok0 + t0 + 1) * 8 + h]; const float x0 = dt0 * aneg, x1 = dt1 * aneg;
            float sc = x0 + x1;
#pragma unroll 1
            for (int o = 1; o < 64; o <<= 1) { const float t = sfrom(sc, lane - o); if (lane >= o) sc += t; }
            const float acs1 = sc, acs0 = sc - x1; const float alast = sfrom(sc, 63);
            dts[wid * 128 + t0] = dt0; dts[wid * 128 + t0 + 1] = dt1; acs[wid * 128 + t0] = acs0; acs[wid * 128 + t0 + 1] = acs1;
            wdec[wid * 128 + t0] = __expf(alast - acs0); wdec[wid * 128 + t0 + 1] = __expf(alast - acs1);
            ACS[(tok0 + t0) * 8 + h] = acs0; ACS[(tok0 + t0 + 1) * 8 + h] = acs1;
            if (lane == 63) CDEC[(size_t)(b * 64 + c) * 8 + h] = expf(acs1);
        }
        __syncthreads();
        { const int seg = tid & 15, chunk = tid >> 4, hh = chunk >> 3, l0 = seg * 8; float o[8][8];
          conv_seg8(P, tok0, c, l0, C_XS + g * 256 + chunk * 8, cw, cb, g * 256 + chunk * 8, o);
          const f32x4 d0 = *(const LAS f32x4*)(dts + hh * 128 + l0), d1 = *(const LAS f32x4*)(dts + hh * 128 + l0 + 4);
#pragma unroll
          for (int i = 0; i < 8; ++i) { u32x4 w; w.x = cvt_pk_bf16(o[0][i] * d0.x, o[1][i] * d0.y); w.y = cvt_pk_bf16(o[2][i] * d0.z, o[3][i] * d0.w);
              w.z = cvt_pk_bf16(o[4][i] * d1.x, o[5][i] * d1.y); w.w = cvt_pk_bf16(o[6][i] * d1.z, o[7][i] * d1.w);
              *(LAS u32x4*)(lds + S1_XD + (chunk * 8 + i) * SROW + l0 * 2) = w; } }
        { const int t = tid & 255, isC = tid >> 8, seg = t & 15, chunk = t >> 4, l0 = seg * 8; float o[8][8];
          conv_seg8(P, tok0, c, l0, (isC ? C_C : C_B) + g * 128 + chunk * 8, cw, cb, (isC ? 768 : 512) + g * 128 + chunk * 8, o);
#pragma unroll
          for (int r = 0; r < 8; ++r) *(u32x4*)(BCA + (tok0 + l0 + r) * 512 + g * 256 + isC * 128 + chunk * 8) = pk8(o[r]);
          if (!isC) {
#pragma unroll
              for (int i = 0; i < 8; ++i) { u32x4 w; w.x = cvt_pk_bf16(o[0][i], o[1][i]); w.y = cvt_pk_bf16(o[2][i], o[3][i]); w.z = cvt_pk_bf16(o[4][i], o[5][i]); w.w = cvt_pk_bf16(o[6][i], o[7][i]);
                  *(LAS u32x4*)(lds + S1_BT + (chunk * 8 + i) * SROW + l0 * 2) = w; } } }
        __syncthreads();
        const int hh = wid >> 1, pt0 = (wid & 1) * 2;
        f32x4 acc[2][8];
#pragma unroll
        for (int pi = 0; pi < 2; ++pi)
#pragma unroll
            for (int nt = 0; nt < 8; ++nt) acc[pi][nt] = (f32x4){0.f, 0.f, 0.f, 0.f};
#pragma unroll
        for (int ks = 0; ks < 4; ++ks) {
            const f32x4 wl = *(const LAS f32x4*)(wdec + hh * 128 + 32 * ks + 4 * fq), wh = *(const LAS f32x4*)(wdec + hh * 128 + 32 * ks + 16 + 4 * fq);
            bf16x8 xf[2];
#pragma unroll
            for (int pi = 0; pi < 2; ++pi) { const LAS unsigned char* ab = lds + S1_XD + (hh * 64 + 16 * (pt0 + pi) + fr) * SROW + (32 * ks + 4 * fq) * 2;
                const u32x2 lo = *(const LAS u32x2*)ab, hi = *(const LAS u32x2*)(ab + 32);
                u32x2 lo2, hi2; lo2.x = cvt_pk_bf16(bflo(lo.x) * wl.x, bfhi(lo.x) * wl.y); lo2.y = cvt_pk_bf16(bflo(lo.y) * wl.z, bfhi(lo.y) * wl.w);
                hi2.x = cvt_pk_bf16(bflo(hi.x) * wh.x, bfhi(hi.x) * wh.y); hi2.y = cvt_pk_bf16(bflo(hi.y) * wh.z, bfhi(hi.y) * wh.w);
                xf[pi] = mk_frag(lo2, hi2); }
#pragma unroll
            for (int nt = 0; nt < 8; ++nt) { const LAS unsigned char* bb = lds + S1_BT + (16 * nt + fr) * SROW + (32 * ks + 4 * fq) * 2;
                const bf16x8 bfg = mk_frag(*(const LAS u32x2*)bb, *(const LAS u32x2*)(bb + 32));
#pragma unroll
                for (int pi = 0; pi < 2; ++pi) acc[pi][nt] = __builtin_amdgcn_mfma_f32_16x16x32_bf16(bfg, xf[pi], acc[pi][nt], 0, 0, 0); }
        }
        bf16* sp = STATES + ((size_t)((b * 64 + c) * 8 + 4 * g + hh) * 64) * 128;
#pragma unroll
        for (int pi = 0; pi < 2; ++pi)
#pragma unroll
            for (int nt = 0; nt < 8; ++nt) *(u32x2*)(sp + (size_t)(16 * (pt0 + pi) + fr) * 128 + 16 * nt + 4 * fq) = pack4(acc[pi][nt]);
        { bf16* xg = XDT + (size_t)((b * 64 + c) * 2 + g) * 256 * 128;
#pragma unroll
          for (int it = 0; it < 8; ++it) { const int task = tid + 512 * it, row = task >> 4, c16 = task & 15;
              *(u32x4*)(xg + row * 128 + c16 * 8) = *(const LAS u32x4*)(lds + S1_XD + row * SROW + c16 * 16); } }
    }
}
__device__ __forceinline__ void ssd2_phase(const Args& a, int wv) {
    unsigned char* ws = a.ws; const unsigned* STATES = (const unsigned*)(OB(a) + DO_STATES); const float* CDEC = (const float*)(ws + WS_CDEC); unsigned* HPREV = (unsigned*)(OB(a) + DO_HPREV);
    for (int idx = blockIdx.x * 512 + opaque_tid(wv); idx < 131072; idx += gridDim.x * 512) {
        const int n2 = idx & 63, p = (idx >> 6) & 63, h = (idx >> 12) & 7, b = idx >> 15;
        float s0 = 0.f, s1 = 0.f;
#pragma unroll 1
        for (int c0 = 0; c0 < 64; c0 += 16) {
            unsigned sv[16]; float dec[16];
#pragma unroll
            for (int k = 0; k < 16; ++k) { const size_t base = ((size_t)((b * 64 + c0 + k) * 8 + h) * 64 + p) * 64 + n2; sv[k] = STATES[base]; dec[k] = CDEC[(size_t)(b * 64 + c0 + k) * 8 + h]; }
            asm volatile("" ::: "memory");
#pragma unroll
            for (int k = 0; k < 16; ++k) { const size_t base = ((size_t)((b * 64 + c0 + k) * 8 + h) * 64 + p) * 64 + n2;
                HPREV[base] = cvt_pk_bf16(s0, s1); s0 = dec[k] * s0 + bflo(sv[k]); s1 = dec[k] * s1 + bfhi(sv[k]); }
        }
    }
}
constexpr int S3_BS = 0, S3_CS = 34816, S3_HP = 0, S3_XD = 69632, S3_DT = 139264, S3_ACS = 141312, S3_GN = 143360;
__device__ __forceinline__ void ssd3_phase(LAS unsigned char* lds, const Args& a, int l, int dry, int wv) {
    const int tid = opaque_tid(wv), lane = tid & 63, wid = __builtin_amdgcn_readfirstlane(tid >> 6), fr = lane & 15, fq = lane >> 4;
    unsigned char* ws = a.ws; const bf16* P = (const bf16*)(ws + WS_PROJ); const float* DT = (const float*)(ws + WS_DT);
    const float* ACS = (const float*)(ws + WS_ACS); const bf16* HPREV = (const bf16*)(OB(a) + DO_HPREV); bf16* MIX = (bf16*)(ws + WS_H);
    const bf16* BCA = (const bf16*)(OB(a) + DO_BCA); const bf16* XDT = (const bf16*)(OB(a) + DO_XDT);
    LAS float* dts = (LAS float*)(lds + S3_DT); LAS float* acs = (LAS float*)(lds + S3_ACS);
    for (int u = blockIdx.x; u < 512; u += gridDim.x) {
        const int g = u & 1, c = (u >> 1) & 63, b = u >> 7; const size_t tok0 = (size_t)b * SEQ + c * 128;
        __syncthreads();
        { const int hh = tid >> 7, lr = tid & 127; const float dv = DT[(tok0 + lr) * 8 + 4 * g + hh], av = ACS[(tok0 + lr) * 8 + 4 * g + hh]; const float gnv = a.in[15][l * 512 + g * 256 + (tid & 255)];
          asm volatile("" ::: "memory"); dts[tid] = dv; acs[tid] = av; if (tid < 256) ((LAS float*)(lds + S3_GN))[tid] = gnv; }
        { u32x4 wb[8], wx[8];
          const bf16* xg = XDT + (size_t)((b * 64 + c) * 2 + g) * 256 * 128;
#pragma unroll
          for (int it = 0; it < 8; ++it) { const int task = tid + 512 * it; wb[it] = *(const u32x4*)(BCA + (tok0 + (task >> 5)) * 512 + g * 256 + (task & 31) * 8);
              wx[it] = *(const u32x4*)(xg + (task >> 4) * 128 + (task & 15) * 8); }
          asm volatile("" ::: "memory");
#pragma unroll
          for (int it = 0; it < 8; ++it) { const int task = tid + 512 * it, row = task >> 5, c16 = task & 31;
              *(LAS u32x4*)(lds + (c16 < 16 ? S3_BS : S3_CS) + row * SROW + (c16 & 15) * 16) = wb[it];
              *(LAS u32x4*)(lds + S3_XD + (task >> 4) * SROW + (task & 15) * 16) = wx[it]; } }
        __syncthreads();
        if (dry == 2) continue;
        u32x4 hpr[8];
        { const bf16* hp = HPREV + (size_t)((b * 64 + c) * 8 + 4 * g) * 64 * 128;
#pragma unroll
          for (int it = 0; it < 8; ++it) { const int task = tid + 512 * it, row = task >> 4, c16 = task & 15; hpr[it] = *(const u32x4*)(hp + row * 128 + c16 * 8); } }
        bf16x8 cfr[4];
#pragma unroll
        for (int ks = 0; ks < 4; ++ks) cfr[ks] = *(const LAS bf16x8*)(lds + S3_CS + (16 * wid + fr) * SROW + (32 * ks + 8 * fq) * 2);
        f32x4 cbt[8];
#pragma unroll
        for (int st = 0; st < 8; ++st) { f32x4 acc = {0.f, 0.f, 0.f, 0.f};
            if (st <= wid) {
#pragma unroll
                for (int ks = 0; ks < 4; ++ks) { const bf16x8 bfA = *(const LAS bf16x8*)(lds + S3_BS + (16 * st + fr) * SROW + (32 * ks + 8 * fq) * 2);
                    acc = __builtin_amdgcn_mfma_f32_16x16x32_bf16(bfA, cfr[ks], acc, 0, 0, 0); } }
            cbt[st] = acc; }
        __syncthreads();
#pragma unroll
        for (int it = 0; it < 8; ++it) { const int task = tid + 512 * it, row = task >> 4, c16 = task & 15; *(LAS u32x4*)(lds + S3_HP + row * SROW + c16 * 16) = hpr[it]; }
        __syncthreads();
        if (dry == 1) continue;
        const size_t qtok = tok0 + 16 * wid + fr;
        float ss = 0.f;
        u32x2 Y[4][4];
#pragma unroll
        for (int q = 0; q < 4; ++q)
#pragma unroll
            for (int pt = 0; pt < 4; ++pt) Y[q][pt] = (u32x2){0u, 0u};
#pragma unroll 1
        for (int hh = 0; hh < 4; ++hh) {
            const int h = 4 * g + hh;
            u32x2 zw[4];
#pragma unroll
            for (int pt = 0; pt < 4; ++pt) zw[pt] = *(const u32x2*)(P + qtok * NPROJ + C_Z + h * 64 + 16 * pt + 4 * fq);
            const float acs_l = acs[hh * 128 + 16 * wid + fr], dt_l = dts[hh * 128 + 16 * wid + fr], dsk = a.in[14][l * 8 + h];
            const float ddiag = dsk / dt_l;
            bf16x8 mf[4];
#pragma unroll
            for (int s2 = 0; s2 < 4; ++s2) {
                f32x4 mv[2];
#pragma unroll
                for (int q = 0; q < 2; ++q) { const int tile = 2 * s2 + q; f32x4 v = {0.f, 0.f, 0.f, 0.f};
                    if (tile <= wid) { const f32x4 as = *(const LAS f32x4*)(acs + hh * 128 + 16 * tile + 4 * fq);
#pragma unroll
                        for (int r = 0; r < 4; ++r) { const int sidx = 16 * tile + 4 * fq + r, lidx = 16 * wid + fr;
                            float val = (sidx <= lidx) ? cbt[tile][r] * __expf(acs_l - as[r]) : 0.f; if (sidx == lidx) val += ddiag; v[r] = val; } }
                    mv[q] = v; }
                mf[s2] = mk_frag(pack4(mv[0]), pack4(mv[1])); }
            f32x4 y[4], yo[4];
#pragma unroll
            for (int pt = 0; pt < 4; ++pt) { y[pt] = (f32x4){0.f, 0.f, 0.f, 0.f}; yo[pt] = (f32x4){0.f, 0.f, 0.f, 0.f}; }
#pragma unroll
            for (int s2 = 0; s2 < 4; ++s2) if (2 * s2 <= wid) {
#pragma unroll
                for (int pt = 0; pt < 4; ++pt) { const LAS unsigned char* ab = lds + S3_XD + (hh * 64 + 16 * pt + fr) * SROW + (32 * s2 + 4 * fq) * 2;
                    y[pt] = __builtin_amdgcn_mfma_f32_16x16x32_bf16(mk_frag(*(const LAS u32x2*)ab, *(const LAS u32x2*)(ab + 32)), mf[s2], y[pt], 0, 0, 0); } }
#pragma unroll
            for (int ks = 0; ks < 4; ++ks)
#pragma unroll
                for (int pt = 0; pt < 4; ++pt) { const bf16x8 hf = *(const LAS bf16x8*)(lds + S3_HP + (hh * 64 + 16 * pt + fr) * SROW + (32 * ks + 8 * fq) * 2);
                    yo[pt] = __builtin_amdgcn_mfma_f32_16x16x32_bf16(hf, cfr[ks], yo[pt], 0, 0, 0); }
            const float el = __expf(acs_l);
#pragma unroll
            for (int pt = 0; pt < 4; ++pt) {
                f32x4 v = y[pt] + yo[pt] * el; v.x *= silu_fast(bflo(zw[pt].x)); v.y *= silu_fast(bfhi(zw[pt].x)); v.z *= silu_fast(bflo(zw[pt].y)); v.w *= silu_fast(bfhi(zw[pt].y));
                ss += (v.x * v.x + v.y * v.y) + (v.z * v.z + v.w * v.w); const u32x2 pv = pack4(v);
#pragma unroll
                for (int q = 0; q < 4; ++q) { Y[q][pt].x = (hh == q) ? pv.x : Y[q][pt].x; Y[q][pt].y = (hh == q) ? pv.y : Y[q][pt].y; } }
        }
        ss += sx(ss, 16, lane); ss += sx(ss, 32, lane);
        const float rstd = 1.0f / sqrtf(ss * (1.0f / 256.f) + EPS);
        const LAS float* gn = (const LAS float*)(lds + S3_GN);
#pragma unroll
        for (int i = 0; i < 16; ++i) { const int hh = i >> 2, pt = i & 3; const f32x4 gv = *(const LAS f32x4*)(gn + hh * 64 + 16 * pt + 4 * fq);
            const u32x2 w = Y[hh][pt]; const f32x4 v = {bflo(w.x), bfhi(w.x), bflo(w.y), bfhi(w.y)};
            *(u32x2*)(MIX + qtok * D + 512 + g * 256 + hh * 64 + 16 * pt + 4 * fq) = pack4(v * rstd * gv); }
    }
}

constexpr int NPHASES = 1 + 7 + 2 + 7 + 1 + NCHUNK + 1;

__global__ void __launch_bounds__(512, 2) mk(Args a) {
    extern __shared__ __attribute__((aligned(16))) unsigned char lds_raw[];
    LAS unsigned char* lds = (LAS unsigned char*)lds_raw;
    volatile LAS unsigned* MISC = (volatile LAS unsigned*)(lds + MISC_OFF);
#if !defined(PROBE_LO)
    const int lo = a.ph_lo, hi = a.ph_hi;
#endif
    unsigned char* ws = a.ws;
    const int wv = __builtin_amdgcn_readfirstlane((int)threadIdx.x >> 6);
    if (wv == 0) MISC[lane_id()] = 0u;
    __syncthreads();
    XcdBarrier bar; bar.bar = (unsigned*)(ws + WS_CTL) + 4096; bar.x = 0; bar.st = MISC + 8; bar.wv = wv;
    if (a.ph_hi - a.ph_lo > 1) bar = xcd_barrier_post((unsigned*)(ws + WS_CTL) + 4096, MISC + 8, wv);
#if defined(PROBE_LO)
#ifndef PROBE_DRY
#define PROBE_DRY 0
#endif
#define DRYV ((pass == 1 && ph < PROBE_HI) ? PROBE_DRY : 0)
  for (int pass = 0; pass < 2; ++pass) {
    const int lo = pass == 0 ? 0 : PROBE_LO, hi = pass == 0 ? PROBE_HI : NPHASES;
    if (pass == 1) xcd_barrier(bar);
#endif
#if !defined(PROBE_LO)
#define DRYV 0
#endif
    int ph = 0;
#define PH_BEGIN if (ph >= lo && ph < hi) {
#define PH_END   if (ph + 1 < hi) { \
        if (!MK_MULTI && ph < TR_BG_NBAR && gridDim.x == 256) XCD_BARRIER_BG(bar, tr_range(lds, a, wv, TR_BG0 + ph * TR_BG_PER, TR_BG0 + (ph + 1) * TR_BG_PER, (int)blockIdx.x * 7 + wv - 1, 256 * 7)); \
        else xcd_barrier(bar); } } ++ph;

    PH_BEGIN prologue_phase(lds, a, wv); PH_END

#pragma unroll 1
    for (int l = 0; l < 2; ++l) {
        const float* Xcur = (l == 0) ? a.in[0] : (const float*)a.out;
        const float* modl = (const float*)(ws + WS_MOD) + (size_t)l * 4 * 6144;
        PH_BEGIN { if (l == 0) norm_phase<0, false, false, true>(lds, a, l, a.in[0], nullptr, wv); else norm_phase<0, false, true>(lds, a, l, ws + WS_XB, nullptr, wv); } PH_END
        PH_BEGIN {
            GemmProb g{(const bf16*)(ws + WS_H), D, (const bf16*)(ws + WS_WIN) + (size_t)l * NPROJ * 1024, 0, nullptr, nullptr, 0, T, 0, NPROJ / 256, 1024, DRYV, WGM_DEF, 0, 0, 1};
            EpiStore E{(bf16*)(ws + WS_PROJ), NPROJ};
            gemm_run<EpiStore, false>(lds, g, E, wv);
            if ((int)blockIdx.x >= 128 && gridDim.x == 256)
                tr_range(lds, a, wv, TR_PRO_END + l * TR_DEFER, TR_PRO_END + (l + 1) * TR_DEFER, ((int)blockIdx.x - 128) * 8 + (opaque_tid(wv) >> 6), 128 * 8);
        } PH_END
        PH_BEGIN {
#if FAST_ATTN
            attn_phase(lds, a, l, wv);
#endif
#if FAST_SSD
            ssd1_phase(lds, a, l, wv);
#endif
        } PH_END
        PH_BEGIN {
#if FAST_SSD
            ssd2_phase(a, wv);
#endif
        } PH_END
        PH_BEGIN {
#if FAST_SSD
            ssd3_phase(lds, a, l, DRYV, wv);
#endif
        } PH_END
        PH_BEGIN {
            GemmProb g{(const bf16*)(ws + WS_H), D, (const bf16*)(ws + WS_WOUT) + (size_t)l * 1024 * 1024, 0, nullptr, nullptr, 0, T, 0, 4, 1024, DRYV, WGM_DEF, 0, 0, 1};
            EpiResid E{(bf16*)(ws + WS_XB), modl + 2 * 1024};
            gemm_run<EpiResid, false>(lds, g, E, wv);
        } PH_END
        if (l == 0) {
            PH_BEGIN norm_phase<1, false, true>(lds, a, l, ws + WS_XB, nullptr, wv); PH_END
            PH_BEGIN {
#if DENSE_GU_FP8
                GemmProb g{ws + WS_H8, D, ws + WS_WFGU, 0, nullptr, nullptr, 0, T, 0, 2 * FFN / 256, 1024, DRYV, WGM_DEF, E8_W, E8_ONE, 1};
                EpiGU E{(bf16*)(ws + WS_ACT), FFN, 0};
                gemm_run<EpiGU, false, true>(lds, g, E, wv);
#else
                GemmProb g{(const bf16*)(ws + WS_H), D, (const bf16*)(ws + WS_WFGU), 0, nullptr, nullptr, 0, T, 0, 2 * FFN / 256, 1024, DRYV, WGM_DEF, 0, 0, 1};
                EpiGU E{(bf16*)(ws + WS_ACT), FFN, 0};
                gemm_run<EpiGU, false>(lds, g, E, wv);
#endif
            } PH_END
            PH_BEGIN {
                GemmProb g{(const bf16*)(ws + WS_ACT), FFN, (const bf16*)(ws + WS_WFD), 0, nullptr, nullptr, 0, T, 0, 4, FFN, DRYV, WGM_DEF, 0, 0, 1};
                EpiResid E{(bf16*)(ws + WS_XB), (const float*)(ws + WS_MOD) + 5 * 1024};
                gemm_run<EpiResid, false>(lds, g, E, wv);
            } PH_END
        } else {
            PH_BEGIN norm_phase<2, false, true>(lds, a, l, ws + WS_XB, nullptr, wv); PH_END
            PH_BEGIN route_phase(lds, a, wv); PH_END
#pragma unroll 1
            for (int j = 0; j < NCHUNK; ++j) {
                const int* meta = (const int*)(ws + WS_META);
                PH_BEGIN {
                    const int nblk = meta[8];
                    const int tb0 = (NCHUNK - 1) * CHB, tb1 = nblk;
                    unsigned char* act_t = OB(a) + DO_ACTM + 2 * ACTM_BYTES;
                    if (j >= 1) {
                        const int jj = j - 1, b0 = jj * CHB, b1 = nblk < b0 + CHB ? nblk : b0 + CHB;
                        unsigned char* act = OB(a) + DO_ACTM + (size_t)(jj & 1) * ACTM_BYTES;
                        if (b1 > b0) {
                            GemmProb g{act, EXPD, ws + WS_WMD, (size_t)1024 * EXPD, nullptr, meta, b0 * 256, (b1 - b0) * 256, b0 * 256, 4, EXPD, DRYV, WGM_DEF, E8_W, E8_ACT, 1};
                            EpiStore E{(bf16*)(ws + WS_Y), D};
                            gemm_run<EpiStore, false, true>(lds, g, E, wv);
                        }
                    }
                    if (j == NCHUNK - 1 && tb1 > tb0) {
                        GemmProb g{act_t, EXPD, ws + WS_WMD, (size_t)1024 * EXPD, nullptr, meta, tb0 * 256, (tb1 - tb0) * 256, tb0 * 256, 4, EXPD, DRYV, WGM_DEF, E8_W, E8_ACT, TAIL_KS};
                        EpiSplit E{(bf16*)(ws + WS_PART), D, 4, (size_t)TAIL_ROWS * D, tb0 * 256};
                        gemm_run<EpiSplit, false, true>(lds, g, E, wv);
                    }
                    if (j < NCHUNK - 1) {
                        const int b0 = j * CHB, b1 = nblk < b0 + CHB ? nblk : b0 + CHB;
                        unsigned char* act = OB(a) + DO_ACTM + (size_t)(j & 1) * ACTM_BYTES;
                        if (b1 > b0) {
                            GemmProb g{ws + WS_H8, D, ws + WS_WMGU, (size_t)7168 * 1024, (const int*)(ws + WS_ROWTOK), meta, b0 * 256, (b1 - b0) * 256, 0, 2 * EXPD / 256, 1024, DRYV, WGM_GU, E8_W, E8_ONE, 1};
                            EpiGU8 E{act, EXPD, b0 * 256};
                            gemm_run<EpiGU8, true, true>(lds, g, E, wv);
                        }
                    }
                    if (j == NCHUNK - 2 && tb1 > tb0) {
                        GemmProb g{ws + WS_H8, D, ws + WS_WMGU, (size_t)7168 * 1024, (const int*)(ws + WS_ROWTOK), meta, tb0 * 256, (tb1 - tb0) * 256, 0, 2 * EXPD / 256, 1024, DRYV, WGM_GU, E8_W, E8_ONE, 1};
                        EpiGU8 E{act_t, EXPD, tb0 * 256};
                        gemm_run<EpiGU8, true, true>(lds, g, E, wv);
                    }
                } PH_END
            }
        }
    }
    PH_BEGIN final_phase(a, wv); PH_END
#if defined(PROBE_LO)
  }
#endif
}

__global__ void __launch_bounds__(512, 2) k_attn_naive(Args a, int l) { attn_naive(a, l); }
__global__ void __launch_bounds__(512, 2) k_ssd_naive_scan(Args a, int l) { ssd_naive_scan(a, l); }
__global__ void __launch_bounds__(512, 2) k_ssd_naive_norm(Args a, int l) { ssd_naive_norm(a, l); }
constexpr int PH_BASE0 = 1, PH_BASE1 = 11;

extern "C" void kernel_launch(void* const* d_in, const int* in_sizes, int n_in, void* d_out, int out_size, void* d_ws, size_t ws_size, hipStream_t stream) {
    static int ready = 0;
    if (!ready) {
        if (n_in != 24 || out_size != T * D || ws_size < WS_END) { fprintf(stderr, "kernel_launch: unexpected problem (n_in %d out %d ws %zu)\n", n_in, out_size, ws_size); ready = -1; return; }
        if (hipFuncSetAttribute((const void*)mk, hipFuncAttributeMaxDynamicSharedMemorySize, LDS_BYTES) != hipSuccess) { fprintf(stderr, "kernel_launch: hipFuncSetAttribute failed\n"); ready = -1; return; }
        ready = 1;
    }
    if (ready < 0) return;
    (void)in_sizes;
    (void)hipMemsetAsync((char*)d_ws + WS_CTL, 0, CTL_BYTES, stream);
    Args a{};
    for (int i = 0; i < 24; ++i) a.in[i] = (const float*)d_in[i];
    a.out = (float*)d_out; a.ws = (unsigned char*)d_ws;
    const int grid = 256;
#if MK_MULTI
    for (int ph = 0; ph < NPHASES; ++ph) {
        int l = -1, off = -1;
        if (ph >= PH_BASE0 && ph < PH_BASE0 + 7) { l = 0; off = ph - PH_BASE0; }
        if (ph >= PH_BASE1 && ph < PH_BASE1 + 7) { l = 1; off = ph - PH_BASE1; }
        if (off == 2) {
#if !FAST_ATTN
            hipLaunchKernelGGL(k_attn_naive, dim3(grid), dim3(512), 0, stream, a, l);
#endif
#if !FAST_SSD
            hipLaunchKernelGGL(k_ssd_naive_scan, dim3(64), dim3(512), 0, stream, a, l);
#endif
        }
#if !FAST_SSD
        if (off == 3) hipLaunchKernelGGL(k_ssd_naive_norm, dim3(grid), dim3(512), 0, stream, a, l);
#endif
        a.ph_lo = ph; a.ph_hi = ph + 1; hipLaunchKernelGGL(mk, dim3(grid), dim3(512), LDS_BYTES, stream, a);
    }
#else
    a.ph_lo = 0; a.ph_hi = NPHASES; hipLaunchKernelGGL(mk, dim3(grid), dim3(512), LDS_BYTES, stream, a);
#endif
}
```

```cpp
#include <hip/hip_runtime.h>
#include <stdio.h>

#ifndef MK_MULTI
#define MK_MULTI 0
#endif
#ifndef GEMM_SP2
#define GEMM_SP2 1
#endif
#ifndef WGM_DEF
#define WGM_DEF 3
#endif
#ifndef DENSE_DOWN_FP8
#define DENSE_DOWN_FP8 1
#endif
#ifndef WGM_GU
#define WGM_GU 2
#endif
#ifndef WGM_N4
#define WGM_N4 2
#endif
#ifndef DENSE_GU_FP8
#define DENSE_GU_FP8 1
#endif
#ifndef FAST_GEMM
#define FAST_GEMM 1
#endif
#ifndef FAST_ATTN
#define FAST_ATTN 1
#endif
#ifndef FAST_SSD
#define FAST_SSD 1
#endif

constexpr int BATCH = 4, SEQ = 8192, T = BATCH * SEQ, D = 1024;
constexpr int NPROJ = 2304, INW = 2312;
constexpr int C_Q = 0, C_K = 512, C_V = 640, C_Z = 768, C_XS = 1280, C_B = 1792, C_C = 2048;
constexpr int FFN = 2816, EXPD = 3584, NEXP = 8;
constexpr int MOE_ROWS = 2 * T + NEXP * 256;
constexpr int CHB = 64;
constexpr int NCHUNK = 5;
constexpr float EPS = 1e-6f;

constexpr size_t MiB = 1u << 20;
constexpr size_t WS_CTL = 0, CTL_BYTES = 1 * MiB;
constexpr size_t WS_MOD = 1 * MiB;
constexpr size_t WS_COS = 2 * MiB, WS_SIN = 6 * MiB;
constexpr size_t WS_TOKE = 10 * MiB;
constexpr size_t WS_TOKG = WS_TOKE + 256 * 1024;
constexpr size_t WS_TOKD = WS_TOKG + 256 * 1024;
constexpr size_t WS_ROWTOK = WS_TOKD + 256 * 1024;
constexpr size_t WS_META = WS_ROWTOK + 512 * 1024;
constexpr size_t WS_WGCNT = WS_META + 4096;
constexpr size_t WS_DT = 12 * MiB;
constexpr size_t WS_ACS = 13 * MiB;
constexpr size_t WS_CDEC = 14 * MiB;
constexpr size_t WS_WIN = 16 * MiB;
constexpr size_t WS_WOUT = 25 * MiB;
constexpr size_t WS_WFGU = 29 * MiB;
constexpr size_t WS_WFD = 40 * MiB;
constexpr size_t WS_WMGU = 46 * MiB;
constexpr size_t WS_WMD = 102 * MiB;
constexpr size_t WS_H8 = 130 * MiB;
constexpr size_t WS_H = 214 * MiB;
constexpr size_t WS_SCR = 279 * MiB;
constexpr size_t WS_PROJ = WS_SCR;
#define OB(a_) ((unsigned char*)(a_).out)
constexpr size_t DO_STATES = 0;
constexpr size_t DO_HPREV = 32 * MiB;
constexpr size_t DO_BCA = 64 * MiB;
constexpr size_t DO_XDT = 96 * MiB;
constexpr size_t DO_DELTA = 0;
constexpr size_t DO_ACTM = 0;
constexpr size_t WS_XB = WS_SCR + 176 * MiB;
constexpr size_t WS_ACT = WS_SCR;
constexpr size_t WS_Y = WS_SCR;
constexpr size_t ACTM_BYTES = (size_t)CHB * 256 * EXPD;
constexpr size_t WS_PART = WS_SCR + 240 * MiB;
constexpr int TAIL_KS = 7, TAIL_ROWS = 8 * 256, TAIL_ROW0 = (NCHUNK - 1) * CHB * 256;
constexpr size_t WS_END = WS_PART + 28 * MiB;
static_assert(WS_END <= 571 * MiB, "ws");

constexpr int LDS_BYTES = 163840;
constexpr int MISC_OFF = 163840 - 256;
constexpr int GIDX_OFF = 131072 + 1024, GIDX_MAXU = 15;

#define GAS __attribute__((address_space(1)))
#define LAS __attribute__((address_space(3)))
typedef unsigned short bf16;
typedef float f32x4 __attribute__((ext_vector_type(4)));
typedef float f32x2 __attribute__((ext_vector_type(2)));
typedef unsigned u32x4 __attribute__((ext_vector_type(4)));
typedef unsigned u32x2 __attribute__((ext_vector_type(2)));
typedef short bf16x8 __attribute__((ext_vector_type(8)));
#define LDS_WAIT() asm volatile("s_waitcnt lgkmcnt(0)" ::: "memory")

__device__ __forceinline__ unsigned f2bf(float f) { unsigned u = __float_as_uint(f); return (u + 0x7fffu + ((u >> 16) & 1u)) >> 16; }
__device__ __forceinline__ unsigned cvt_pk_bf16(float lo, float hi) { unsigned r; asm volatile("v_cvt_pk_bf16_f32 %0, %1, %2" : "=v"(r) : "v"(lo), "v"(hi)); return r; }
__device__ __forceinline__ unsigned pk2(float lo, float hi) { return cvt_pk_bf16(lo, hi); }
__device__ __forceinline__ float bflo(unsigned w) { return __uint_as_float(w << 16); }
__device__ __forceinline__ float bfhi(unsigned w) { return __uint_as_float(w & 0xffff0000u); }
__device__ __forceinline__ float bf2f(bf16 b) { return __uint_as_float((unsigned)b << 16); }
__device__ __forceinline__ u32x2 pack4(f32x4 v) { u32x2 r; r.x = pk2(v.x, v.y); r.y = pk2(v.z, v.w); return r; }
__device__ __forceinline__ float silu_f(float v) { return v / (1.0f + __expf(-v)); }
__device__ __forceinline__ float silu_fast(float v) { return v * __builtin_amdgcn_rcpf(1.0f + __expf(-v)); }
__device__ __forceinline__ int lane_id() { int l; asm volatile("v_mbcnt_lo_u32_b32 %0, -1, 0\n\tv_mbcnt_hi_u32_b32 %0, -1, %0" : "=v"(l)); return l; }
__device__ __forceinline__ int opaque_tid(int wv) { int t = wv * 64 + lane_id(); asm volatile("" : "+v"(t)); return t; }
__device__ __forceinline__ float sx(float v, int o, int lane) { return __int_as_float(__builtin_amdgcn_ds_bpermute((lane ^ o) << 2, __float_as_int(v))); }
__device__ __forceinline__ float sfrom(float v, int src) { return __int_as_float(__builtin_amdgcn_ds_bpermute(src << 2, __float_as_int(v))); }
template <int CTRL> __device__ __forceinline__ float dpp_f(float v) { return __int_as_float(__builtin_amdgcn_update_dpp(0, __float_as_int(v), CTRL, 0xF, 0xF, true)); }
__device__ __forceinline__ float wave_sum(float v, int lane) {
    (void)lane;
    v += dpp_f<0xB1>(v); v += dpp_f<0x4E>(v); v += dpp_f<0x141>(v); v += dpp_f<0x140>(v);
    const int iv = __float_as_int(v);
    return (__int_as_float(__builtin_amdgcn_readlane(iv, 0)) + __int_as_float(__builtin_amdgcn_readlane(iv, 16))) + (__int_as_float(__builtin_amdgcn_readlane(iv, 32)) + __int_as_float(__builtin_amdgcn_readlane(iv, 48)));
}

__device__ const float INVF[32] = {1.0f, 0.7498942613601685f, 0.5623413324356079f, 0.4216965138912201f, 0.3162277638912201f, 0.23713737726211548f, 0.17782793939113617f, 0.133352130651474f, 0.10000000149011612f, 0.07498941570520401f, 0.05623413249850273f, 0.04216965287923813f, 0.03162277489900589f, 0.023713737726211548f, 0.017782794311642647f, 0.01333521492779255f, 0.009999999776482582f, 0.007498941849917173f, 0.005623413249850273f, 0.0042169648222625256f, 0.003162277629598975f, 0.00237137358635664f, 0.0017782794311642647f, 0.0013335214462131262f, 0.0010000000474974513f, 0.0007498942431993783f, 0.000562341301701963f, 0.0004216965171508491f, 0.0003162277571391314f, 0.00023713737027719617f, 0.00017782794020604342f, 0.0001333521504420787f};

#define XB_TMO      128
#define XB_XCNT(j)  (256  + 64 * (j))
#define XB_XSUB(j)  (1280 + 64 * (j))
#define XB_XGEN(j)  (2304 + 64 * (j))
#define XB_TOP      3328
#define XB_TOPGEN   3392
#define XCD_BAR_WORDS 3456
#define XB_SPIN_CAP (1u << 18)
__device__ __forceinline__ unsigned xb_ld(unsigned* p)              { return __hip_atomic_load(p, __ATOMIC_RELAXED, __HIP_MEMORY_SCOPE_AGENT); }
__device__ __forceinline__ unsigned xb_add(unsigned* p, unsigned v) { return __hip_atomic_fetch_add(p, v, __ATOMIC_RELAXED, __HIP_MEMORY_SCOPE_AGENT); }
__device__ __forceinline__ unsigned xb_xcc_id() { return (unsigned)__builtin_amdgcn_s_getreg((3 << 11) | 20) & 0xFu; }
#define XB_SPIN(cond, bar) do { unsigned _sp = 0; while (cond) { __builtin_amdgcn_s_sleep(1); \
    if ((++_sp & 255u) == 0u) { if (xb_ld(&(bar)[XB_TMO])) break; if (_sp > XB_SPIN_CAP) { atomicAdd(&(bar)[XB_TMO], 1u); break; } } } } while (0)
struct XcdBarrier { unsigned* bar; unsigned x; volatile LAS unsigned* st; int wv; };
__device__ __forceinline__ XcdBarrier xcd_barrier_post(unsigned* bar, volatile LAS unsigned* st, int wv) {
    XcdBarrier b; b.bar = bar; b.x = xb_xcc_id(); b.st = st; b.wv = wv;
    if (wv == 0 && lane_id() == 0) (void)xb_add(&bar[XB_XCNT(b.x)], 1u);
    return b;
}
__device__ __forceinline__ void xcd_barrier_complete(unsigned* bar, unsigned x, unsigned& nloc, unsigned& nx) {
    const unsigned G = gridDim.x * gridDim.y * gridDim.z;
    unsigned sum, cnt, mine, sp = 0u;
    for (;;) {
        sum = 0u; cnt = 0u; mine = 0u;
#pragma unroll
        for (unsigned j = 0; j < 16; ++j) { const unsigned c = xb_ld(&bar[XB_XCNT(j)]); sum += c; cnt += (c > 0u) ? 1u : 0u; mine = (j == x) ? c : mine; }
        if (sum == G) break;
        __builtin_amdgcn_s_sleep(1);
        if ((++sp & 255u) == 0u) { if (xb_ld(&bar[XB_TMO])) break; if (sp > XB_SPIN_CAP) { atomicAdd(&bar[XB_TMO], 1u); break; } }
    }
    nloc = mine > 0u ? mine : 1u; nx = cnt > 0u ? cnt : 1u;
}
__device__ __forceinline__ void xcd_barrier_leader(const XcdBarrier& b) {
    if (lane_id() == 0) {
        unsigned* bar = b.bar;
        asm volatile("" : "+s"(bar));
        __builtin_amdgcn_s_waitcnt(0);
        unsigned nloc = b.st[0], nx = b.st[1];
        if (nloc == 0u) { xcd_barrier_complete(bar, b.x, nloc, nx); b.st[0] = nloc; b.st[1] = nx; }
        const unsigned old = xb_add(&bar[XB_XSUB(b.x)], 1u);
        const unsigned gen = old / nloc;
        if (old + 1u == (gen + 1u) * nloc) {
            __builtin_amdgcn_fence(__ATOMIC_RELEASE, "agent");
            asm volatile("s_waitcnt vmcnt(0)" ::: "memory");
            const unsigned og = xb_add(&bar[XB_TOP], 1u);
            const unsigned tg = og / nx;
            if (og + 1u == (tg + 1u) * nx) {
#pragma unroll
                for (unsigned j = 0; j < 16; ++j) (void)xb_add(&bar[XB_XGEN(j)], 1u);
            } else XB_SPIN(xb_ld(&bar[XB_XGEN(b.x)]) == gen, bar);
            __builtin_amdgcn_fence(__ATOMIC_ACQUIRE, "agent");
            asm volatile("s_waitcnt vmcnt(0)" ::: "memory");
        } else {
            XB_SPIN(xb_ld(&bar[XB_XGEN(b.x)]) == gen, bar);
            __builtin_amdgcn_fence(__ATOMIC_ACQUIRE, "agent");
            asm volatile("s_waitcnt vmcnt(0)" ::: "memory");
        }
    }
}
__device__ __forceinline__ void xcd_barrier(const XcdBarrier& b) {
    asm volatile("s_waitcnt vmcnt(0)" ::: "memory");
    __syncthreads();
    if (b.wv == 0) xcd_barrier_leader(b);
    __syncthreads();
}

#define XCD_BARRIER_BG(b_, BG_STMT) do { \
    asm volatile("s_waitcnt vmcnt(0)" ::: "memory"); __syncthreads(); \
    if ((b_).wv == 0) xcd_barrier_leader(b_); else { BG_STMT; } \
    __syncthreads(); } while (0)

struct GemmProb {
    const void* A; int lda;
    const void* Bt; size_t bstride;
    const int* row_idx;
    const int* pad_end;
    int row0, nrows;
    int a_row_sub;
    int nN;
    int K;
    int dry;
    int wgm;
    int sclW, sclA;
    int ksplit;
};
__device__ __forceinline__ u32x4 pack8(f32x4 a, f32x4 b) { u32x4 w; w.x = cvt_pk_bf16(a.x, a.y); w.y = cvt_pk_bf16(a.z, a.w); w.z = cvt_pk_bf16(b.x, b.y); w.w = cvt_pk_bf16(b.z, b.w); return w; }
struct EpiStore { bf16* O; int ldc;
    __device__ __forceinline__ void row8(int row, int pn, int c8, f32x4 lo0, f32x4 lo1, f32x4 hi0, f32x4 hi1) const {
        bf16* p = O + (size_t)row * ldc + pn * 256 + c8; *(u32x4*)p = pack8(lo0, lo1); *(u32x4*)(p + 128) = pack8(hi0, hi1); } };
struct EpiResid { bf16* X; const float* gate;
    struct Ctx { f32x4 g0, g1, g2, g3; };
    __device__ __forceinline__ Ctx begin(int row0, int pn, int c8) const { const float* gp = gate + (size_t)(row0 / SEQ) * 6144 + pn * 256 + c8;
        Ctx c; c.g0 = *(const f32x4*)gp; c.g1 = *(const f32x4*)(gp + 4); c.g2 = *(const f32x4*)(gp + 128); c.g3 = *(const f32x4*)(gp + 132); return c; }
    __device__ __forceinline__ void row8(const Ctx& c, int row, int pn, int c8, f32x4 lo0, f32x4 lo1, f32x4 hi0, f32x4 hi1) const {
        bf16* p = X + (size_t)row * D + pn * 256 + c8; const u32x4 x0 = *(const u32x4*)p, x1 = *(const u32x4*)(p + 128);
        lo0 = c.g0 * lo0 + (f32x4){bflo(x0.x), bfhi(x0.x), bflo(x0.y), bfhi(x0.y)}; lo1 = c.g1 * lo1 + (f32x4){bflo(x0.z), bfhi(x0.z), bflo(x0.w), bfhi(x0.w)};
        hi0 = c.g2 * hi0 + (f32x4){bflo(x1.x), bfhi(x1.x), bflo(x1.y), bfhi(x1.y)}; hi1 = c.g3 * hi1 + (f32x4){bflo(x1.z), bfhi(x1.z), bflo(x1.w), bfhi(x1.w)};
        *(u32x4*)p = pack8(lo0, lo1); *(u32x4*)(p + 128) = pack8(hi0, hi1); } };
template <class E> struct epi_has_ctx { static constexpr bool value = false; };
template <> struct epi_has_ctx<EpiResid> { static constexpr bool value = true; };
struct EpiSplit { bf16* O; int ldc; int nN; size_t part_stride; int row_sub;
    __device__ __forceinline__ void row8(int row, int pnp, int c8, f32x4 lo0, f32x4 lo1, f32x4 hi0, f32x4 hi1) const {
        const int ks = pnp / nN, pn = pnp - ks * nN;
        bf16* p = O + (size_t)ks * part_stride + (size_t)(row - row_sub) * ldc + pn * 256 + c8; *(u32x4*)p = pack8(lo0, lo1); *(u32x4*)(p + 128) = pack8(hi0, hi1); } };
#ifndef FP8_SAT_MODE
#define FP8_SAT_MODE 1
#endif
__device__ __forceinline__ float clamp448(float v) { return FP8_SAT_MODE ? v : __builtin_amdgcn_fmed3f(v, -448.0f, 448.0f); }
__device__ __forceinline__ unsigned pk4_fp8(float a, float b, float c, float d) { int p = 0; p = __builtin_amdgcn_cvt_pk_fp8_f32(clamp448(a), clamp448(b), p, false); p = __builtin_amdgcn_cvt_pk_fp8_f32(clamp448(c), clamp448(d), p, true); return (unsigned)p; }
constexpr float W8_SCALE = 64.0f, ACT8_SCALE = 8.0f;
constexpr int E8_ONE = 0x7f7f7f7f, E8_W = 0x79797979, E8_ACT = 0x7c7c7c7c;
constexpr float GATE_PRE = 1.44269504f;
__device__ __forceinline__ void swiglu8(f32x4 g0, f32x4 g1, f32x4 u0, f32x4 u1, float s_inv, f32x4& o0, f32x4& o1) {
    const float c = s_inv * GATE_PRE;
    const f32x4 gu0 = g0 * u0, gu1 = g1 * u1;
    f32x4 e0, e1;
#pragma unroll
    for (int i = 0; i < 4; ++i) { e0[i] = __builtin_amdgcn_exp2f(__builtin_amdgcn_fmed3f(-g0[i], -3.0e38f, 60.0f)); e1[i] = __builtin_amdgcn_exp2f(__builtin_amdgcn_fmed3f(-g1[i], -3.0e38f, 60.0f)); }
    __builtin_amdgcn_sched_barrier(0);
    const f32x4 d0 = e0 * c + c, d1 = e1 * c + c;
    const float r0 = __builtin_amdgcn_rcpf(d0.x * d0.y), r1 = __builtin_amdgcn_rcpf(d0.z * d0.w), r2 = __builtin_amdgcn_rcpf(d1.x * d1.y), r3 = __builtin_amdgcn_rcpf(d1.z * d1.w);
    __builtin_amdgcn_sched_barrier(0);
    const f32x4 i0 = {d0.y * r0, d0.x * r0, d0.w * r1, d0.z * r1}, i1 = {d1.y * r2, d1.x * r2, d1.w * r3, d1.z * r3};
    o0 = gu0 * i0; o1 = gu1 * i1;
}
struct EpiGU8 { unsigned char* O; int ldc; int row_sub;
    __device__ __forceinline__ void row8(int row, int pn, int c8, f32x4 lo0, f32x4 lo1, f32x4 hi0, f32x4 hi1) const {
        f32x4 a, b; swiglu8(lo0, lo1, hi0, hi1, 1.0f / ACT8_SCALE, a, b);
        u32x2 w; w.x = pk4_fp8(a.x, a.y, a.z, a.w); w.y = pk4_fp8(b.x, b.y, b.z, b.w);
        *(u32x2*)(O + (size_t)(row - row_sub) * ldc + pn * 128 + c8) = w; } };
struct EpiGU { bf16* O; int ldc; int row_sub;
    __device__ __forceinline__ void row8(int row, int pn, int c8, f32x4 lo0, f32x4 lo1, f32x4 hi0, f32x4 hi1) const {
        f32x4 a, b; swiglu8(lo0, lo1, hi0, hi1, 1.0f, a, b);
        *(u32x4*)(O + (size_t)(row - row_sub) * ldc + pn * 128 + c8) = pack8(a, b); } };


constexpr int BM = 256, BK = 64, HALF = 128, HTB = HALF * BK * 2, NXCD = 8, WGM = 2;
__device__ __forceinline__ int lds_byte(int r, int c) { const int st = (r >> 4) * 2 + (c >> 5), rr = r & 15, cc = c & 31, ob = rr * 64 + cc * 2; return st * 1024 + (ob ^ (((ob >> 9) & 1) << 5)); }
__device__ __forceinline__ int perm32(int rho) { const int n = rho >> 4, i = rho & 15; return 8 * (i >> 2) + 4 * n + (i & 3); }
__device__ __forceinline__ void stage_rc(int b, int& R, int& C) { const int st = b / 1024, sb = b % 1024, swz = sb ^ (((sb >> 9) & 1) << 5); R = (st >> 1) * 16 + swz / 64; C = (st & 1) * 32 + (swz % 64) / 2; }
struct FUnit { int pm, pn; };
struct FOrder {
    int nM, nN, nwg, G, c, wgm;
    __device__ __forceinline__ void init(int nM_, int nN_, int G_, int c_, int wgm_) { nM = nM_; nN = nN_; nwg = nM * nN; G = G_; c = c_; wgm = wgm_; }
    __device__ __forceinline__ bool next(int i, FUnit& u) const {
        const long L = (long)i * G + c; if (L >= nwg) return false;
        int wgid = (int)L; { const int q = nwg / NXCD, r = nwg % NXCD, xcd = wgid % NXCD, off = wgid / NXCD; wgid = (xcd < r ? xcd * (q + 1) : r * (q + 1) + (xcd - r) * q) + off; }
        const int nig = wgm * nN, gid = wgid / nig, fm = gid * wgm, gsz = (nM - fm) < wgm ? (nM - fm) : wgm;
        u.pm = fm + ((wgid % nig) % gsz); u.pn = (wgid % nig) / gsz; return true;
    }
};

typedef int v8i __attribute__((ext_vector_type(8)));
typedef int i32x4 __attribute__((ext_vector_type(4)));
__device__ __forceinline__ v8i cat8(bf16x8 a, bf16x8 b) { const u32x4 x = __builtin_bit_cast(u32x4, a), y = __builtin_bit_cast(u32x4, b); v8i r = {(int)x.x, (int)x.y, (int)x.z, (int)x.w, (int)y.x, (int)y.y, (int)y.z, (int)y.w}; return r; }
template <bool F8> struct Frag { bf16x8 h[2]; };
template <> struct Frag<true> { v8i v; };
__device__ __forceinline__ f32x4 zero4() { f32x2 a, b; asm volatile("v_mov_b64 %0, 0" : "=v"(a)); asm volatile("v_mov_b64 %0, 0" : "=v"(b)); return __builtin_shufflevector(a, b, 0, 1, 2, 3); }
template <class Epi, bool GATHER, bool FP8>
__device__ __forceinline__ void gemm_fast(LAS unsigned char* lds, const GemmProb& g, const Epi& E, int wv) {
    const int tid = opaque_tid(wv), wid = __builtin_amdgcn_readfirstlane(tid >> 6), lane = tid & 63, wr = wid >> 2, wc = wid & 3, fr = lane & 15, fq = lane >> 4;
    constexpr int ESZ = FP8 ? 1 : 2;
    const int K = g.K * ESZ, klen = K / g.ksplit, nt = (g.dry == 2) ? 2 : klen / (BK * 2), lda = g.lda * ESZ;
    FOrder S; S.init(g.nrows / BM, g.nN * g.ksplit, (int)gridDim.x, (int)blockIdx.x, g.wgm);
    int Rr[2], Cc[2]; unsigned voffB[2];
#pragma unroll
    for (int i = 0; i < 2; ++i) { stage_rc(tid * 16 + i * 8192, Rr[i], Cc[i]); const int Rb = (Rr[i] & ~31) + perm32(Rr[i] & 31); voffB[i] = (unsigned)(Rb * K + Cc[i] * 2); }
    const size_t kstep = (size_t)(BK * 2);
    const size_t hstepB = (size_t)HALF * K;
    const unsigned ldsw = (unsigned)wid * 1024u;
    const int aoff = lds_byte(wr * 64 + fr, fq * 8), boff = lds_byte(wc * 32 + fr, fq * 8);
#define G_SA(b, h) (((b) * 2 + (h)) * HTB)
#define G_SB(b, h) ((4 + (b) * 2 + (h)) * HTB)
#define G_STAGE(bufoff, gbase, voff) do { _Pragma("unroll") for (int _i = 0; _i < 2; ++_i) \
        __builtin_amdgcn_global_load_lds((const unsigned*)((const char*)(gbase) + (voff)[_i]), (LAS unsigned*)(lds + (bufoff) + ldsw + _i * 8192), 16, 0, 0); } while (0)
#define G_LD8(p_) __builtin_shufflevector(*(const LAS i32x4*)(p_), *(const LAS i32x4*)((p_) + 1024), 0, 1, 2, 3, 4, 5, 6, 7)
#define G_LDF(dst, p_) do { if constexpr (FP8) { (dst).v = G_LD8(p_); } else { (dst).h[0] = *(const LAS bf16x8*)(p_); (dst).h[1] = *(const LAS bf16x8*)((p_) + 1024); } } while (0)
#define G_LDA(dst, b, h) do { if (g.dry == 4) break; _Pragma("unroll") for (int m = 0; m < 4; ++m) G_LDF(dst[m], lds + G_SA(b, h) + aoff + m * 2048); } while (0)
#define G_LDB(dst, b, h) do { if (g.dry == 4) break; _Pragma("unroll") for (int n = 0; n < 2; ++n) G_LDF(dst[n], lds + G_SB(b, h) + boff + n * 2048); } while (0)
#define G_MMA(ai, bj, At, Bt) do { if (g.dry == 3) break; __builtin_amdgcn_s_setprio(1); \
        if constexpr (FP8) { _Pragma("unroll") for (int m = 0; m < 4; ++m) _Pragma("unroll") for (int n = 0; n < 2; ++n) \
            asm volatile("v_mfma_scale_f32_16x16x128_f8f6f4 %0, %1, %2, %0, %3, %4 op_sel_hi:[0,0,0]" : "+v"(acc[ai][bj][m][n]) : "v"(Bt[n].v), "v"(At[m].v), "v"(sW_), "v"(sA_)); } \
        else { _Pragma("unroll") for (int m = 0; m < 4; ++m) _Pragma("unroll") for (int n = 0; n < 2; ++n) _Pragma("unroll") for (int k = 0; k < 2; ++k) \
            acc[ai][bj][m][n] = __builtin_amdgcn_mfma_f32_16x16x32_bf16(Bt[n].h[k], At[m].h[k], acc[ai][bj][m][n], 0, 0, 0); } \
        __builtin_amdgcn_s_setprio(0); } while (0)
#define G_WAIT_V(n) asm volatile("s_waitcnt vmcnt(" #n ")" ::: "memory")
#define G_WAIT_L(n) asm volatile("s_waitcnt lgkmcnt(" #n ")" ::: "memory")
#define G_BAR do { if (g.dry != 5) __builtin_amdgcn_s_barrier(); } while (0)
#define G_SCHED __builtin_amdgcn_sched_barrier(0)
    LAS int* GIDX = (LAS int*)(lds + GIDX_OFF);
#define G_AOFF(dst, u, ui_) do { const int _lr = g.row0 + (u).pm * BM; _Pragma("unroll") for (int _h = 0; _h < 2; ++_h) _Pragma("unroll") for (int _i = 0; _i < 2; ++_i) { \
        const int _ar = GATHER ? GIDX[(ui_) * 256 + _h * HALF + Rr[_i]] : (_lr + _h * HALF + Rr[_i] - g.a_row_sub); dst[_h][_i] = (unsigned)(_ar * lda + Cc[_i] * 2 + ((u).pn / g.nN) * klen); } } while (0)
    int pe0 = 0x7fffffff, pe1 = 0x7fffffff, pe2 = 0x7fffffff, pe3 = 0x7fffffff, pe4 = 0x7fffffff, pe5 = 0x7fffffff, pe6 = 0x7fffffff;
    if (g.pad_end) { pe0 = g.pad_end[0]; pe1 = g.pad_end[1]; pe2 = g.pad_end[2]; pe3 = g.pad_end[3]; pe4 = g.pad_end[4]; pe5 = g.pad_end[5]; pe6 = g.pad_end[6]; }
#define G_BPTR(u, out) do { const int _r = g.row0 + (u).pm * BM; const int _e = (_r >= pe0) + (_r >= pe1) + (_r >= pe2) + (_r >= pe3) + (_r >= pe4) + (_r >= pe5) + (_r >= pe6); \
        const int _ks = (u).pn / g.nN, _pn = (u).pn - _ks * g.nN; out = (const char*)g.Bt + (size_t)_e * g.bstride * ESZ + (size_t)_pn * BM * K + (size_t)_ks * klen; } while (0)
    if (GATHER) {
        FUnit u_;
        for (int i_ = 0; i_ < GIDX_MAXU && S.next(i_, u_); ++i_) if (tid < 256) GIDX[i_ * 256 + tid] = g.row_idx[g.row0 + u_.pm * BM + tid];
        __syncthreads();
    }
    const int sW_ = g.sclW, sA_ = g.sclA; (void)sW_; (void)sA_;
    FUnit cur, nxt; int ui = 0;
    if (!S.next(0, cur)) return;
    f32x4 acc[2][2][4][2];
#pragma unroll
    for (int a_ = 0; a_ < 2; ++a_)
#pragma unroll
        for (int b_ = 0; b_ < 2; ++b_)
#pragma unroll
            for (int m = 0; m < 4; ++m)
#pragma unroll
                for (int n = 0; n < 2; ++n) acc[a_][b_][m][n] = zero4();
    Frag<FP8> At[4], B0[2], B1[2];
    unsigned cOff[2][2], nOff[2][2];
    const char* cB; const char* nB;
    const char* gA = (const char*)g.A;
    G_AOFF(cOff, cur, 0); G_BPTR(cur, cB);
#if GEMM_SP2
    G_STAGE(G_SB(0, 0), cB, voffB); G_STAGE(G_SB(0, 1), cB + hstepB, voffB); G_STAGE(G_SA(0, 0), gA, cOff[0]); G_STAGE(G_SA(0, 1), gA, cOff[1]);
    if (wr == 1) G_BAR;
    G_WAIT_V(2); G_BAR;
    G_STAGE(G_SB(1, 0), cB + kstep, voffB); G_STAGE(G_SA(1, 0), gA + kstep, cOff[0]); G_STAGE(G_SB(1, 1), cB + hstepB + kstep, voffB);
    G_WAIT_V(6); G_BAR;
#else
    G_STAGE(G_SB(0, 0), cB, voffB); G_STAGE(G_SA(0, 0), gA, cOff[0]); G_STAGE(G_SB(0, 1), cB + hstepB, voffB); G_STAGE(G_SA(0, 1), gA, cOff[1]);
    if (wr == 1) G_BAR;
    G_WAIT_V(4); G_BAR;
    G_STAGE(G_SB(1, 0), cB + kstep, voffB); G_STAGE(G_SA(1, 0), gA + kstep, cOff[0]); G_STAGE(G_SB(1, 1), cB + hstepB + kstep, voffB);
    G_WAIT_V(6); G_BAR;
#endif
    for (;;) {
        const bool has_next = S.next(ui + 1, nxt);
        if (has_next) { G_AOFF(nOff, nxt, ui + 1); G_BPTR(nxt, nB); }
        else {
#pragma unroll
            for (int h_ = 0; h_ < 2; ++h_)
#pragma unroll
                for (int i_ = 0; i_ < 2; ++i_) nOff[h_][i_] = cOff[h_][i_];
            nB = cB; }
        for (int t = 0; t < nt; t += 2) {
            const bool last = (t == nt - 2);
            const char* a1 = gA + (size_t)(t + 1) * kstep;
            const char* a2 = last ? gA : gA + (size_t)(t + 2) * kstep; const char* b2 = last ? nB : cB + (size_t)(t + 2) * kstep;
            const char* a3 = a2 + kstep; const char* b3 = b2 + kstep;
            unsigned o2[2][2];
#pragma unroll
            for (int h_ = 0; h_ < 2; ++h_)
#pragma unroll
                for (int i_ = 0; i_ < 2; ++i_) o2[h_][i_] = last ? nOff[h_][i_] : cOff[h_][i_];
#if GEMM_SP2
            G_LDB(B0, 0, 0); G_LDB(B1, 0, 1); G_SCHED; G_LDA(At, 0, 0); G_STAGE(G_SA(1, 1), a1, cOff[1]);
            G_WAIT_V(8); G_WAIT_L(0); G_BAR; G_MMA(0, 0, At, B0); G_MMA(0, 1, At, B1); G_BAR; G_SCHED;
            G_LDA(At, 0, 1); G_STAGE(G_SB(0, 0), b2, voffB); G_STAGE(G_SB(0, 1), b2 + hstepB, voffB); G_STAGE(G_SA(0, 0), a2, o2[0]);
            G_WAIT_V(8); G_WAIT_L(0); G_BAR; G_MMA(1, 0, At, B0); G_MMA(1, 1, At, B1); G_BAR; G_SCHED;
            G_LDB(B0, 1, 0); G_LDB(B1, 1, 1); G_SCHED; G_LDA(At, 1, 0); G_STAGE(G_SA(0, 1), a2, o2[1]);
            G_WAIT_V(8); G_WAIT_L(0); G_BAR; G_MMA(0, 0, At, B0); G_MMA(0, 1, At, B1); G_BAR; G_SCHED;
            G_LDA(At, 1, 1); G_STAGE(G_SB(1, 0), b3, voffB); G_STAGE(G_SB(1, 1), b3 + hstepB, voffB); G_STAGE(G_SA(1, 0), a3, o2[0]);
            G_WAIT_V(8); G_WAIT_L(0); G_BAR; G_MMA(1, 0, At, B0); G_MMA(1, 1, At, B1); G_BAR; G_SCHED;
#else
            G_LDB(B0, 0, 0); G_SCHED; G_LDA(At, 0, 0); G_STAGE(G_SA(1, 1), a1, cOff[1]);
            G_WAIT_L(8); G_BAR; G_WAIT_L(0); G_MMA(0, 0, At, B0); G_BAR; G_SCHED;
            G_LDB(B1, 0, 1); G_STAGE(G_SB(0, 0), b2, voffB);
            G_BAR; G_WAIT_L(0); G_MMA(0, 1, At, B1); G_BAR;
            G_LDA(At, 0, 1); G_STAGE(G_SA(0, 0), a2, o2[0]);
            G_BAR; G_WAIT_L(0); G_MMA(1, 0, At, B0); G_BAR; G_SCHED;
            G_STAGE(G_SB(0, 1), b2 + hstepB, voffB);
            G_WAIT_V(6); G_BAR; G_MMA(1, 1, At, B1); G_BAR;
            G_LDB(B0, 1, 0); G_SCHED; G_LDA(At, 1, 0); G_STAGE(G_SA(0, 1), a2, o2[1]);
            G_WAIT_L(8); G_BAR; G_WAIT_L(0); G_MMA(0, 0, At, B0); G_BAR; G_SCHED;
            G_LDB(B1, 1, 1); G_STAGE(G_SB(1, 0), b3, voffB);
            G_BAR; G_WAIT_L(0); G_MMA(0, 1, At, B1); G_BAR;
            G_LDA(At, 1, 1); G_STAGE(G_SA(1, 0), a3, o2[0]);
            G_BAR; G_WAIT_L(0); G_MMA(1, 0, At, B0); G_BAR; G_SCHED;
            G_STAGE(G_SB(1, 1), b3 + hstepB, voffB);
            G_WAIT_V(6); G_BAR; G_MMA(1, 1, At, B1); G_BAR;
#endif
        }
        if (wr == 0) G_BAR;
        {
            const int rowb = g.row0 + cur.pm * BM + wr * 64 + fr, c8 = wc * 32 + 8 * fq;
            if (!g.dry) {
              if constexpr (epi_has_ctx<Epi>::value) {
                const auto ctx = E.begin(g.row0 + cur.pm * BM, cur.pn, c8);
#pragma unroll
                for (int ai = 0; ai < 2; ++ai)
#pragma unroll
                    for (int m = 0; m < 4; ++m) E.row8(ctx, rowb + ai * HALF + m * 16, cur.pn, c8, acc[ai][0][m][0], acc[ai][0][m][1], acc[ai][1][m][0], acc[ai][1][m][1]);
              } else {
#pragma unroll
                for (int ai = 0; ai < 2; ++ai)
#pragma unroll
                    for (int m = 0; m < 4; ++m) E.row8(rowb + ai * HALF + m * 16, cur.pn, c8, acc[ai][0][m][0], acc[ai][0][m][1], acc[ai][1][m][0], acc[ai][1][m][1]);
              }
            }
        }
        if (!has_next) break;
#pragma unroll
        for (int a_ = 0; a_ < 2; ++a_)
#pragma unroll
            for (int b_ = 0; b_ < 2; ++b_)
#pragma unroll
                for (int m = 0; m < 4; ++m)
#pragma unroll
                    for (int n = 0; n < 2; ++n) acc[a_][b_][m][n] = zero4();
        cur = nxt; cB = nB; ++ui;
#pragma unroll
        for (int h_ = 0; h_ < 2; ++h_)
#pragma unroll
            for (int i_ = 0; i_ < 2; ++i_) cOff[h_][i_] = nOff[h_][i_];
        if (wr == 1) G_BAR;
    }
    G_WAIT_V(0);
    G_BAR;
#undef G_SA
#undef G_SB
#undef G_STAGE
#undef G_LD8
#undef G_LDF
#undef G_LDA
#undef G_LDB
#undef G_MMA
#undef G_WAIT_V
#undef G_WAIT_L
#undef G_BAR
#undef G_SCHED
#undef G_AOFF
#undef G_BPTR
}

template <class Epi, bool GATHER, bool FP8 = false>
__device__ __forceinline__ void gemm_run(LAS unsigned char* lds, const GemmProb& g, const Epi& E, int wv) {
    gemm_fast<Epi, GATHER, FP8>(lds, g, E, wv);
}

__device__ __forceinline__ void tr_item(const float* W, int ldw, int K, int k0, int n0, bf16* WT, int dst_row0, LAS float* scr, int lane) {
    f32x4 v[8];
#pragma unroll
    for (int j = 0; j < 8; ++j) v[j] = *(const f32x4*)(W + (size_t)(k0 + 8 * j + (lane >> 3)) * ldw + n0 + 4 * (lane & 7));
#pragma unroll
    for (int j = 0; j < 8; ++j) { LAS float* d = scr + (8 * j + (lane >> 3)) * 33 + 4 * (lane & 7); d[0] = v[j].x; d[1] = v[j].y; d[2] = v[j].z; d[3] = v[j].w; }
    LDS_WAIT(); asm volatile("" ::: "memory");
    const int c = lane & 7;
#pragma unroll
    for (int j = 0; j < 4; ++j) { const int n = (lane >> 3) + 8 * j; const LAS float* sp = scr + (8 * c) * 33 + n;
        u32x4 o; o.x = pk2(sp[0 * 33], sp[1 * 33]); o.y = pk2(sp[2 * 33], sp[3 * 33]); o.z = pk2(sp[4 * 33], sp[5 * 33]); o.w = pk2(sp[6 * 33], sp[7 * 33]);
        *(u32x4*)(WT + (size_t)(dst_row0 + n) * K + k0 + 8 * c) = o; }
    LDS_WAIT(); asm volatile("" ::: "memory");
}
__device__ __forceinline__ void tr_item8(const float* W, int ldw, int K, int k0, int n0, unsigned char* WT, int dst_row0, LAS float* scr, int lane) {
    f32x4 v[8];
#pragma unroll
    for (int j = 0; j < 8; ++j) v[j] = *(const f32x4*)(W + (size_t)(k0 + 8 * j + (lane >> 3)) * ldw + n0 + 4 * (lane & 7));
#pragma unroll
    for (int j = 0; j < 8; ++j) { LAS float* d = scr + (8 * j + (lane >> 3)) * 33 + 4 * (lane & 7); d[0] = v[j].x; d[1] = v[j].y; d[2] = v[j].z; d[3] = v[j].w; }
    LDS_WAIT(); asm volatile("" ::: "memory");
    const int c = lane & 7;
#pragma unroll
    for (int j = 0; j < 4; ++j) { const int n = (lane >> 3) + 8 * j; const LAS float* sp = scr + (8 * c) * 33 + n;
        u32x2 o; o.x = pk4_fp8(W8_SCALE * sp[0 * 33], W8_SCALE * sp[1 * 33], W8_SCALE * sp[2 * 33], W8_SCALE * sp[3 * 33]); o.y = pk4_fp8(W8_SCALE * sp[4 * 33], W8_SCALE * sp[5 * 33], W8_SCALE * sp[6 * 33], W8_SCALE * sp[7 * 33]);
        *(u32x2*)(WT + (size_t)(dst_row0 + n) * K + k0 + 8 * c) = o; }
    LDS_WAIT(); asm volatile("" ::: "memory");
}
__device__ __forceinline__ int gu_row(int n0) { return (n0 >> 7) * 256 + (n0 & 127); }

__device__ __forceinline__ void sincos_acc(float angf, float& s, float& c) {
    const double a = (double)angf;
    const double n = rint(a * 0.15915494309189535);
    double r = fma(-n, 6.283185307179586, a); r = fma(-n, 2.4492935982947064e-16, r);
    const double r2 = r * r;
    double ts = 1.0, tc = 1.0, ss = 1.0, cs = 1.0;
#pragma unroll
    for (int k = 1; k <= 14; ++k) { tc *= r2 * (-1.0 / (double)((2 * k - 1) * (2 * k))); cs += tc; ts *= r2 * (-1.0 / (double)((2 * k) * (2 * k + 1))); ss += ts; }
    s = (float)(r * ss); c = (float)cs;
}

struct Args { const float* in[24]; float* out; unsigned char* ws; int ph_lo, ph_hi; };

constexpr int TR_I_IN = 16 * 72, TR_I_OUT = 16 * 32, TR_I_FG = 16 * 88, TR_I_FD = 44 * 32, TR_I_MG = 16 * 112, TR_I_MD = 56 * 32;
constexpr int TR_NITEMS = 2 * TR_I_IN + 2 * TR_I_OUT + 2 * TR_I_FG + TR_I_FD + 16 * TR_I_MG + 8 * TR_I_MD;
constexpr int TR_DEFER = 7168;
constexpr int TR_PRO_END = TR_NITEMS - 2 * TR_DEFER;
constexpr int TR_BG0 = 2 * TR_I_IN + 2 * TR_I_OUT + 2 * TR_I_FG + TR_I_FD;
constexpr int TR_BG_PER = 256 * 7, TR_BG_NBAR = (TR_PRO_END - TR_BG0) / TR_BG_PER;
static_assert(TR_BG0 + TR_BG_NBAR * TR_BG_PER == TR_PRO_END && TR_BG_NBAR == 16, "background conversion split");
__device__ __forceinline__ void tr_range(LAS unsigned char* lds, const Args& a, int wv, int it_lo, int it_hi, int rank, int nrank) {
    const int tid = opaque_tid(wv), lane = tid & 63, wave = tid >> 6; unsigned char* ws = a.ws;
    {
        LAS float* scr = (LAS float*)(lds + wave * 16384);
        const int gw = it_lo + rank, NGW = nrank;
        constexpr int I_IN = TR_I_IN, I_OUT = TR_I_OUT, I_FG = TR_I_FG, I_FD = TR_I_FD, I_MG = TR_I_MG, I_MD = TR_I_MD;
        struct TrIt { const float* W; unsigned char* dst; int ldw, K, k0, n0, row0, f8; float sc; };
        auto decode = [&](int it) -> TrIt { TrIt t; int r = it;
            if (r < 2 * I_IN) { const int l = r / I_IN; r %= I_IN; const int kb = r / 72, nb = r % 72; t = TrIt{a.in[7] + (size_t)l * 1024 * INW, ws + WS_WIN + (size_t)l * NPROJ * 1024 * 2, INW, 1024, kb * 64, nb * 32, nb * 32, 0, 1.0f}; return t; }
            r -= 2 * I_IN;
            if (r < 2 * I_OUT) { const int l = r / I_OUT; r %= I_OUT; const int kb = r / 32, nb = r % 32; t = TrIt{a.in[8] + (size_t)l * 1024 * 1024, ws + WS_WOUT + (size_t)l * 1024 * 1024 * 2, 1024, 1024, kb * 64, nb * 32, nb * 32, 0, 1.0f}; return t; }
            r -= 2 * I_OUT;
            if (r < 2 * I_FG) { const int up = r / I_FG; r %= I_FG; const int kb = r / 88, nb = r % 88; t = TrIt{a.in[16 + up], ws + WS_WFGU, FFN, 1024, kb * 64, nb * 32, gu_row(nb * 32) + up * 128, DENSE_GU_FP8, up ? 1.0f : GATE_PRE}; return t; }
            r -= 2 * I_FG;
            if (r < I_FD) { const int kb = r / 32, nb = r % 32; t = TrIt{a.in[18], ws + WS_WFD, 1024, FFN, kb * 64, nb * 32, nb * 32, DENSE_DOWN_FP8, 1.0f}; return t; }
            r -= I_FD;
            if (r < 16 * I_MG) { const int up = r / (8 * I_MG); r %= 8 * I_MG; const int e = r / I_MG; r %= I_MG; const int kb = r / 112, nb = r % 112;
                t = TrIt{a.in[20 + up] + (size_t)e * 1024 * EXPD, ws + WS_WMGU + (size_t)e * 7168 * 1024, EXPD, 1024, kb * 64, nb * 32, gu_row(nb * 32) + up * 128, 1, up ? 1.0f : GATE_PRE}; return t; }
            r -= 16 * I_MG;
            { const int e = r / I_MD; r %= I_MD; const int kb = r / 32, nb = r % 32; t = TrIt{a.in[22] + (size_t)e * EXPD * 1024, ws + WS_WMD + (size_t)e * 1024 * EXPD, 1024, EXPD, kb * 64, nb * 32, nb * 32, 1, 1.0f}; return t; } };
        f32x4 v[8], vn[8];
        TrIt cur{}, nxt{};
        if (gw < it_hi) { cur = decode(gw);
#pragma unroll
            for (int j = 0; j < 8; ++j) v[j] = __builtin_nontemporal_load((const f32x4*)(cur.W + (size_t)(cur.k0 + 8 * j + (lane >> 3)) * cur.ldw + cur.n0 + 4 * (lane & 7))); }
        for (int it = gw; it < it_hi; it += NGW) {
            const bool more = it + NGW < it_hi;
            if (more) { nxt = decode(it + NGW);
#pragma unroll
                for (int j = 0; j < 8; ++j) vn[j] = __builtin_nontemporal_load((const f32x4*)(nxt.W + (size_t)(nxt.k0 + 8 * j + (lane >> 3)) * nxt.ldw + nxt.n0 + 4 * (lane & 7))); }
            asm volatile("" ::: "memory");
#pragma unroll
            for (int j = 0; j < 8; ++j) { LAS float* d = scr + (8 * j + (lane >> 3)) * 33 + 4 * (lane & 7); d[0] = v[j].x; d[1] = v[j].y; d[2] = v[j].z; d[3] = v[j].w; }
            LDS_WAIT(); asm volatile("" ::: "memory");
            const int c = lane & 7;
#pragma unroll
            for (int j = 0; j < 4; ++j) { const int n = (lane >> 3) + 8 * j; const LAS float* sp = scr + (8 * c) * 33 + n;
                if (cur.f8) { const float ws8 = W8_SCALE * cur.sc; u32x2 o; o.x = pk4_fp8(ws8 * sp[0 * 33], ws8 * sp[1 * 33], ws8 * sp[2 * 33], ws8 * sp[3 * 33]); o.y = pk4_fp8(ws8 * sp[4 * 33], ws8 * sp[5 * 33], ws8 * sp[6 * 33], ws8 * sp[7 * 33]);
                    *(u32x2*)(cur.dst + (size_t)(cur.row0 + n) * cur.K + cur.k0 + 8 * c) = o; }
                else { const float wsc = cur.sc; u32x4 o; o.x = pk2(wsc * sp[0 * 33], wsc * sp[1 * 33]); o.y = pk2(wsc * sp[2 * 33], wsc * sp[3 * 33]); o.z = pk2(wsc * sp[4 * 33], wsc * sp[5 * 33]); o.w = pk2(wsc * sp[6 * 33], wsc * sp[7 * 33]);
                    *(u32x4*)(cur.dst + ((size_t)(cur.row0 + n) * cur.K + cur.k0 + 8 * c) * 2) = o; } }
            LDS_WAIT(); asm volatile("" ::: "memory");
            cur = nxt;
#pragma unroll
            for (int j = 0; j < 8; ++j) v[j] = vn[j];
        }
    }
}

__device__ __forceinline__ void prologue_phase(LAS unsigned char* lds, const Args& a, int wv) {
    const int tid = opaque_tid(wv), lane = tid & 63, wave = tid >> 6, G = gridDim.x;
    unsigned char* ws = a.ws;
    {
        LAS float* cact = (LAS float*)lds;
        LAS float* red = (LAS float*)(lds + 16384);
        const float* c = a.in[1];
        for (int i = tid; i < 4096; i += 512) cact[i] = silu_f(c[i]);
        __syncthreads();
        float* MOD = (float*)(ws + WS_MOD);
        for (int u = blockIdx.x; u < 192; u += G) {
            const int l = u / 96, j0 = (u % 96) * 64;
            const float* W = a.in[3] + (size_t)l * 1024 * 6144;
            const int col = tid & 63, kg = tid >> 6;
            float acc0 = 0.f, acc1 = 0.f, acc2 = 0.f, acc3 = 0.f;
#pragma unroll 1
            for (int k0 = kg * 128; k0 < kg * 128 + 128; k0 += 32) {
                float w[32];
#pragma unroll
                for (int q = 0; q < 32; ++q) w[q] = __builtin_nontemporal_load(W + (size_t)(k0 + q) * 6144 + j0 + col);
                asm volatile("" ::: "memory");
#pragma unroll
                for (int q = 0; q < 32; ++q) { const int k = k0 + q; acc0 += cact[k] * w[q]; acc1 += cact[1024 + k] * w[q]; acc2 += cact[2048 + k] * w[q]; acc3 += cact[3072 + k] * w[q]; } }
            red[(kg * 4 + 0) * 64 + col] = acc0; red[(kg * 4 + 1) * 64 + col] = acc1; red[(kg * 4 + 2) * 64 + col] = acc2; red[(kg * 4 + 3) * 64 + col] = acc3;
            __syncthreads();
            if (tid < 256) { const int b = tid >> 6, cc = tid & 63; float s = 0.f;
#pragma unroll
                for (int q = 0; q < 8; ++q) s += red[(q * 4 + b) * 64 + cc];
                MOD[(size_t)(l * 4 + b) * 6144 + j0 + cc] = s + a.in[4][l * 6144 + j0 + cc]; }
            __syncthreads();
        }
    }
    {
        const int* pos = (const int*)a.in[2];
        float* COS = (float*)(ws + WS_COS); float* SIN = (float*)(ws + WS_SIN);
        for (int e = blockIdx.x * 512 + tid; e < T * 32; e += G * 512) {
            const int tok = e >> 5, i = e & 31; const float ang = (float)pos[tok] * INVF[i];
            float s, c; sincos_acc(ang, s, c); COS[e] = c; SIN[e] = s; }
    }
    if (blockIdx.x == 0) { unsigned* hp = (unsigned*)((bf16*)(ws + WS_H) + (size_t)T * D); for (int i = tid; i < 256 * D / 2; i += 512) hp[i] = 0u;
                           unsigned* h8 = (unsigned*)(ws + WS_H8 + (size_t)T * D); for (int i = tid; i < 256 * D / 4; i += 512) h8[i] = 0u; }
    __syncthreads();
    tr_range(lds, a, wv, 0, (MK_MULTI || G != 256) ? TR_PRO_END : TR_BG0, blockIdx.x * 8 + wave, G * 8);
}

template <int MODE, bool DELTA, bool XBF, bool WRX = false>
__device__ __forceinline__ void norm_phase(LAS unsigned char* lds, const Args& a, int l, const void* Xin, const float* dgate, int wv) {
    const int tid = opaque_tid(wv), lane = tid & 63, wave = tid >> 6, G = gridDim.x;
    unsigned char* ws = a.ws;
    const int rpw = T / G, r0 = blockIdx.x * rpw, b = r0 / SEQ;
    const float* gain = a.in[MODE == 0 ? 5 : 6] + l * D;
    const float* modb = (const float*)(ws + WS_MOD) + (size_t)(l * 4 + b) * 6144 + (MODE == 0 ? 0 : 3 * 1024);
    bf16* H = (bf16*)(ws + WS_H); const bf16* DL = (const bf16*)(OB(a) + DO_DELTA);
    f32x4 gs[4], sh[4], gd[4];
#pragma unroll
    for (int j = 0; j < 4; ++j) { const int col = 4 * lane + 256 * j; const f32x4 g = *(const f32x4*)(gain + col), sc = *(const f32x4*)(modb + 1024 + col);
        gs[j] = g * (1.0f + sc); sh[j] = *(const f32x4*)(modb + col); gd[j] = DELTA ? *(const f32x4*)(dgate + b * 6144 + col) : (f32x4){0.f, 0.f, 0.f, 0.f}; }
    LAS f32x4* WA = (LAS f32x4*)lds;
    LAS f32x4* WB = (LAS f32x4*)(lds + 16384);
    if (MODE != 1) {
        const float* W8 = MODE == 0 ? a.in[7] + (size_t)l * 1024 * INW + NPROJ : a.in[19];
        const int ldw = MODE == 0 ? INW : 8;
        for (int idx = tid; idx < 1024; idx += 512) { const int je = idx >> 6, ln = idx & 63; const int k = 256 * (je >> 2) + 4 * ln + (je & 3);
            const float* wp = W8 + (size_t)k * ldw;
            WA[idx] = (f32x4){wp[0], wp[1], wp[2], wp[3]}; WB[idx] = (f32x4){wp[4], wp[5], wp[6], wp[7]}; }
        __syncthreads();
    }
    LAS int* wge = (LAS int*)(lds + 32768);
    f32x4 xn[2][4]; u32x2 xb[2][4]; u32x2 dn[2][4];
    bf16* XBo = (bf16*)(ws + WS_XB);
#define N_LOADROW(u_, row_) do { const f32x4* xr = (const f32x4*)((const float*)Xin + (size_t)(row_) * D) + lane; const u32x2* xq = (const u32x2*)((const bf16*)Xin + (size_t)(row_) * D) + lane; \
        const u32x2* dr = (const u32x2*)(DL + (size_t)(row_) * D) + lane; \
        _Pragma("unroll") for (int j = 0; j < 4; ++j) { if (XBF) xb[u_][j] = xq[64 * j]; else xn[u_][j] = __builtin_nontemporal_load(xr + 64 * j); if (DELTA) dn[u_][j] = dr[64 * j]; } } while (0)
#pragma unroll
    for (int u = 0; u < 2; ++u) N_LOADROW(u, r0 + wave + 8 * u);
#pragma unroll 1
    for (int i0 = wave; i0 < rpw; i0 += 16) {
        asm volatile("" ::: "memory");
        f32x4 vv[2][4];
#pragma unroll
        for (int u = 0; u < 2; ++u)
#pragma unroll
            for (int j = 0; j < 4; ++j) { vv[u][j] = XBF ? (f32x4){bflo(xb[u][j].x), bfhi(xb[u][j].x), bflo(xb[u][j].y), bfhi(xb[u][j].y)} : xn[u][j];
                if (DELTA) { const f32x4 dv = {bflo(dn[u][j].x), bfhi(dn[u][j].x), bflo(dn[u][j].y), bfhi(dn[u][j].y)}; vv[u][j] += gd[j] * dv; } }
        if (i0 + 16 < rpw) {
#pragma unroll
            for (int u = 0; u < 2; ++u) N_LOADROW(u, r0 + i0 + 16 + 8 * u); }
#undef N_LOADROW
      f32x4 vr[2][4];
#pragma unroll
      for (int u = 0; u < 2; ++u) {
        const int i = i0 + 8 * u, row = r0 + i;
        f32x4 v[4]; float ss = 0.f;
#pragma unroll
        for (int j = 0; j < 4; ++j) v[j] = vv[u][j];
        if (DELTA || WRX) { u32x2* xo = (u32x2*)(XBo + (size_t)row * D) + lane;
#pragma unroll
            for (int j = 0; j < 4; ++j) { u32x2 w; w.x = cvt_pk_bf16(v[j].x, v[j].y); w.y = cvt_pk_bf16(v[j].z, v[j].w); xo[64 * j] = w; } }
#pragma unroll
        for (int j = 0; j < 4; ++j) ss += (v[j].x * v[j].x + v[j].y * v[j].y) + (v[j].z * v[j].z + v[j].w * v[j].w);
        ss = wave_sum(ss, lane);
        const float rstd = 1.0f / sqrtf(ss * (1.0f / D) + EPS);
        u32x2* o8 = (u32x2*)(H + (size_t)row * D) + lane; unsigned* o4 = (unsigned*)(ws + WS_H8 + (size_t)row * D) + lane;
#pragma unroll
        for (int j = 0; j < 4; ++j) { v[j] = v[j] * rstd * gs[j] + sh[j]; vr[u][j] = v[j];
            if (MODE == 2 || (MODE == 1 && DENSE_GU_FP8)) o4[64 * j] = pk4_fp8(v[j].x, v[j].y, v[j].z, v[j].w);
            else { u32x2 w; w.x = cvt_pk_bf16(v[j].x, v[j].y); w.y = cvt_pk_bf16(v[j].z, v[j].w); o8[64 * j] = w; } }
      }
      if (MODE != 1) {
        f32x4 a0[2], a1[2];
#pragma unroll
        for (int u = 0; u < 2; ++u) { a0[u] = (f32x4){0.f, 0.f, 0.f, 0.f}; a1[u] = (f32x4){0.f, 0.f, 0.f, 0.f}; }
#pragma unroll
        for (int j = 0; j < 4; ++j)
#pragma unroll
            for (int e = 0; e < 4; ++e) { const f32x4 wa = WA[(4 * j + e) * 64 + lane], wb = WB[(4 * j + e) * 64 + lane];
                a0[0] += vr[0][j][e] * wa; a1[0] += vr[0][j][e] * wb; a0[1] += vr[1][j][e] * wa; a1[1] += vr[1][j][e] * wb; }
        float w8[8];
#pragma unroll
        for (int o = 0; o < 8; ++o) { const float x0 = (o < 4) ? a0[0][o & 3] : a1[0][o & 3], x1 = (o < 4) ? a0[1][o & 3] : a1[1][o & 3];
            const auto r = __builtin_amdgcn_permlane32_swap(__float_as_uint(x0), __float_as_uint(x1), false, false); w8[o] = __uint_as_float(r[0]) + __uint_as_float(r[1]); }
        float z[4];
#pragma unroll
        for (int o = 0; o < 4; ++o) { const auto r = __builtin_amdgcn_permlane16_swap(__float_as_uint(w8[o]), __float_as_uint(w8[o + 4]), false, false); float t = __uint_as_float(r[0]) + __uint_as_float(r[1]);
            t += dpp_f<0xB1>(t); t += dpp_f<0x4E>(t); t += dpp_f<0x141>(t); t += dpp_f<0x140>(t); z[o] = t; }
        if (MODE == 0) {
            const int o = lane & 3, head = o + 4 * ((lane >> 4) & 1), urow = r0 + i0 + 8 * (lane >> 5);
            float my = z[0]; my = (o == 1) ? z[1] : my; my = (o == 2) ? z[2] : my; my = (o == 3) ? z[3] : my;
            if ((lane & 12) == 0) { const float xx = my + a.in[12][l * 8 + head];
                const float ex = __expf(-fabsf(xx)); const float l1p = (ex < 1e-3f) ? ex * (1.0f - 0.5f * ex) : __logf(1.0f + ex);
                const float sp = fmaxf(xx, 0.f) + l1p;
                ((float*)(ws + WS_DT))[(size_t)urow * 8 + head] = sp; }
        } else {
#pragma unroll
          for (int u = 0; u < 2; ++u) {
            const int i = i0 + 8 * u, row = r0 + i;
            float acc[8];
#pragma unroll
            for (int o = 0; o < 8; ++o) acc[o] = __int_as_float(__builtin_amdgcn_readlane(__float_as_int(z[o & 3]), 32 * u + 16 * (o >> 2)));
            int i0x = 0; float v0 = acc[0];
#pragma unroll
            for (int o = 1; o < 8; ++o) if (acc[o] > v0) { v0 = acc[o]; i0x = o; }
            int i1x = -1; float v1 = -3.0e38f;
#pragma unroll
            for (int o = 0; o < 8; ++o) if (o != i0x && acc[o] > v1) { v1 = acc[o]; i1x = o; }
            const float ee = expf(v1 - v0), g0 = 1.0f / (1.0f + ee), g1 = ee / (1.0f + ee);
            if (lane == 0) { ((int*)(ws + WS_TOKE))[row * 2] = i0x; ((int*)(ws + WS_TOKE))[row * 2 + 1] = i1x;
                ((float*)(ws + WS_TOKG))[row * 2] = g0; ((float*)(ws + WS_TOKG))[row * 2 + 1] = g1;
                wge[i * 2] = i0x; wge[i * 2 + 1] = i1x; }
          }
        }
      }
    }
    if (MODE == 2) {
        __syncthreads();
        const int na = rpw * 2;
        for (int aidx = tid; aidx < na; aidx += 512) { const int e = wge[aidx]; int rank = 0; for (int q = 0; q < aidx; ++q) rank += (wge[q] == e) ? 1 : 0;
            ((int*)(ws + WS_TOKD))[(size_t)r0 * 2 + aidx] = rank; }
        if (tid < 8) { int cnt = 0; for (int q = 0; q < na; ++q) cnt += (wge[q] == tid) ? 1 : 0; ((int*)(ws + WS_WGCNT))[blockIdx.x * 8 + tid] = cnt; }
        __syncthreads();
    }
}

__device__ __forceinline__ void route_phase(LAS unsigned char* lds, const Args& a, int wv) {
    const int tid = opaque_tid(wv), G = gridDim.x; unsigned char* ws = a.ws;
    const int rpw = T / G, r0 = blockIdx.x * rpw;
    LAS int* cnt = (LAS int*)lds;
    LAS int* tot = cnt + G * 8;
    LAS int* base = tot + 8;
    LAS int* ps = base + 8;
    LAS int* pe = ps + 8;
    const int* wgc = (const int*)(ws + WS_WGCNT);
    { const int lane = tid & 63, e = tid >> 6; int c4[4];
#pragma unroll
      for (int k = 0; k < 4; ++k) c4[k] = (4 * lane + k < G) ? wgc[(4 * lane + k) * 8 + e] : 0;
      asm volatile("" ::: "memory");
      const int mine = c4[0] + c4[1] + c4[2] + c4[3]; int inc = mine;
#pragma unroll
      for (int o = 1; o < 64; o <<= 1) { const int t = __builtin_amdgcn_ds_bpermute((lane - o) << 2, inc); if (lane >= o) inc += t; }
      if (lane == 63) tot[e] = inc;
      if (lane == ((int)blockIdx.x >> 2)) { int bs = inc - mine; const int kb = (int)blockIdx.x & 3; if (kb > 0) bs += c4[0]; if (kb > 1) bs += c4[1]; if (kb > 2) bs += c4[2]; base[e] = bs; } }
    __syncthreads();
    if (tid == 0) { int acc = 0; for (int e = 0; e < 8; ++e) { ps[e] = acc; acc += (tot[e] + 255) / 256 * 256; pe[e] = acc; } }
    __syncthreads();
    int* tokd = (int*)(ws + WS_TOKD); const int* toke = (const int*)(ws + WS_TOKE); int* rowtok = (int*)(ws + WS_ROWTOK);
    for (int aidx = tid; aidx < rpw * 2; aidx += 512) { const size_t gi = (size_t)r0 * 2 + aidx; const int e = toke[gi]; const int dest = ps[e] + base[e] + tokd[gi];
        tokd[gi] = dest; rowtok[dest] = r0 + (aidx >> 1); }
    if (blockIdx.x < 8) { const int e = blockIdx.x; for (int r = ps[e] + tot[e] + tid; r < pe[e]; r += 512) rowtok[r] = T; }
    if (blockIdx.x == 0 && tid < 8) { ((int*)(ws + WS_META))[tid] = pe[tid]; if (tid == 7) ((int*)(ws + WS_META))[8] = pe[7] / 256; }
}

__device__ __forceinline__ void final_phase(const Args& a, int wv) {
    const int tid = opaque_tid(wv), lane = tid & 63, wave = __builtin_amdgcn_readfirstlane(tid >> 6), G = gridDim.x; unsigned char* ws = a.ws;
    const float* gfin = a.in[23];
    const bf16* Y = (const bf16*)(ws + WS_Y);
    const int* tokd = (const int*)(ws + WS_TOKD); const float* tokg = (const float*)(ws + WS_TOKG);
    const int rpv = T / (G * 8);
    const int base = (blockIdx.x * 8 + wave) * rpv;
    int md0 = 0, md1 = 0; float mg0 = 0.f, mg1 = 0.f;
    if (lane < rpv) { md0 = tokd[(base + lane) * 2]; md1 = tokd[(base + lane) * 2 + 1]; mg0 = tokg[(base + lane) * 2]; mg1 = tokg[(base + lane) * 2 + 1]; }
    const int b = base / SEQ;
    const float* gf = (const float*)(ws + WS_MOD) + (size_t)(4 + b) * 6144 + 5 * 1024;
    f32x4 gfv[4], gfn[4];
#pragma unroll
    for (int j = 0; j < 4; ++j) { gfv[j] = *(const f32x4*)(gf + 4 * lane + 256 * j); gfn[j] = *(const f32x4*)(gfin + 4 * lane + 256 * j); }
    const bf16* PART = (const bf16*)(ws + WS_PART);
    u32x2 xn[4], y0n[4], y1n[4]; const bf16* XBi = (const bf16*)(ws + WS_XB);
    int cd0 = __builtin_amdgcn_readlane(md0, 0), cd1 = __builtin_amdgcn_readlane(md1, 0);
    { const u32x2* xr = (const u32x2*)(XBi + (size_t)base * D) + lane;
      const u32x2* p0 = (const u32x2*)(cd0 < TAIL_ROW0 ? Y + (size_t)cd0 * D : PART + (size_t)(cd0 - TAIL_ROW0) * D) + lane;
      const u32x2* p1 = (const u32x2*)(cd1 < TAIL_ROW0 ? Y + (size_t)cd1 * D : PART + (size_t)(cd1 - TAIL_ROW0) * D) + lane;
#pragma unroll
      for (int j = 0; j < 4; ++j) { xn[j] = __builtin_nontemporal_load(xr + 64 * j); y0n[j] = __builtin_nontemporal_load(p0 + 64 * j); y1n[j] = __builtin_nontemporal_load(p1 + 64 * j); } }
#pragma unroll 1
    for (int i = 0; i < rpv; ++i) {
        const int row = base + i;
        const float g0f = __int_as_float(__builtin_amdgcn_readlane(__float_as_int(mg0), i)), g1f = __int_as_float(__builtin_amdgcn_readlane(__float_as_int(mg1), i));
        f32x4 ya[4], yb[4];
#pragma unroll
        for (int j = 0; j < 4; ++j) { ya[j] = (f32x4){bflo(y0n[j].x), bfhi(y0n[j].x), bflo(y0n[j].y), bfhi(y0n[j].y)}; yb[j] = (f32x4){bflo(y1n[j].x), bfhi(y1n[j].x), bflo(y1n[j].y), bfhi(y1n[j].y)}; }
        if (cd0 >= TAIL_ROW0) { const u32x2* pp = (const u32x2*)(PART + (size_t)(cd0 - TAIL_ROW0) * D) + lane;
            for (int sp = 1; sp < TAIL_KS; ++sp)
#pragma unroll
                for (int j = 0; j < 4; ++j) { const u32x2 w = pp[(size_t)sp * TAIL_ROWS * D / 4 + 64 * j]; ya[j] += (f32x4){bflo(w.x), bfhi(w.x), bflo(w.y), bfhi(w.y)}; } }
        if (cd1 >= TAIL_ROW0) { const u32x2* pp = (const u32x2*)(PART + (size_t)(cd1 - TAIL_ROW0) * D) + lane;
            for (int sp = 1; sp < TAIL_KS; ++sp)
#pragma unroll
                for (int j = 0; j < 4; ++j) { const u32x2 w = pp[(size_t)sp * TAIL_ROWS * D / 4 + 64 * j]; yb[j] += (f32x4){bflo(w.x), bfhi(w.x), bflo(w.y), bfhi(w.y)}; } }
        f32x4 v[4]; float ss = 0.f;
#pragma unroll
        for (int j = 0; j < 4; ++j) { v[j] = (f32x4){bflo(xn[j].x), bfhi(xn[j].x), bflo(xn[j].y), bfhi(xn[j].y)} + gfv[j] * (g0f * ya[j] + g1f * yb[j]); ss += (v[j].x * v[j].x + v[j].y * v[j].y) + (v[j].z * v[j].z + v[j].w * v[j].w); }
        if (i + 1 < rpv) {
            cd0 = __builtin_amdgcn_readlane(md0, i + 1); cd1 = __builtin_amdgcn_readlane(md1, i + 1);
            const u32x2* xr = (const u32x2*)(XBi + (size_t)(row + 1) * D) + lane;
            const u32x2* p0 = (const u32x2*)(cd0 < TAIL_ROW0 ? Y + (size_t)cd0 * D : PART + (size_t)(cd0 - TAIL_ROW0) * D) + lane;
            const u32x2* p1 = (const u32x2*)(cd1 < TAIL_ROW0 ? Y + (size_t)cd1 * D : PART + (size_t)(cd1 - TAIL_ROW0) * D) + lane;
#pragma unroll
            for (int j = 0; j < 4; ++j) { xn[j] = __builtin_nontemporal_load(xr + 64 * j); y0n[j] = __builtin_nontemporal_load(p0 + 64 * j); y1n[j] = __builtin_nontemporal_load(p1 + 64 * j); } }
        ss = wave_sum(ss, lane);
        const float rstd = 1.0f / sqrtf(ss * (1.0f / D) + EPS);
        f32x4* xo = (f32x4*)(a.out + (size_t)row * D) + lane;
#pragma unroll
        for (int j = 0; j < 4; ++j) __builtin_nontemporal_store(v[j] * rstd * gfn[j], xo + 64 * j);
    }
}

__device__ __forceinline__ void attn_naive(const Args& a, int l) {
    unsigned char* ws = a.ws; const bf16* P = (const bf16*)(ws + WS_PROJ); bf16* MIX = (bf16*)(ws + WS_H);
    const float* COS = (const float*)(ws + WS_COS); const float* SIN = (const float*)(ws + WS_SIN);
    for (int idx = blockIdx.x * 512 + threadIdx.x; idx < T * 8; idx += gridDim.x * 512) {
        const int tok = idx >> 3, h = idx & 7, kvh = h >> 2, b = tok / SEQ, s = tok % SEQ;
        float q[64];
        { const u32x4* qp = (const u32x4*)(P + (size_t)tok * NPROJ + C_Q + h * 64);
#pragma unroll
          for (int c = 0; c < 4; ++c) { const u32x4 w0 = qp[c], w1 = qp[c + 4];
              const float x1[8] = {bflo(w0.x), bfhi(w0.x), bflo(w0.y), bfhi(w0.y), bflo(w0.z), bfhi(w0.z), bflo(w0.w), bfhi(w0.w)};
              const float x2[8] = {bflo(w1.x), bfhi(w1.x), bflo(w1.y), bfhi(w1.y), bflo(w1.z), bfhi(w1.z), bflo(w1.w), bfhi(w1.w)};
#pragma unroll
              for (int i = 0; i < 8; ++i) { const float cs = COS[tok * 32 + c * 8 + i], sn = SIN[tok * 32 + c * 8 + i];
                  q[c * 8 + i] = x1[i] * cs - x2[i] * sn; q[32 + c * 8 + i] = x2[i] * cs + x1[i] * sn; } } }
        float m = a.in[9][l * 8 + h], lsum = 1.0f; float acc[64];
#pragma unroll
        for (int i = 0; i < 64; ++i) acc[i] = 0.f;
        const int jlo = s - 127 > 0 ? s - 127 : 0;
        for (int j = jlo; j <= s; ++j) {
            const int tk = b * SEQ + j;
            const u32x4* kp = (const u32x4*)(P + (size_t)tk * NPROJ + C_K + kvh * 64);
            float sc = 0.f;
#pragma unroll
            for (int c = 0; c < 4; ++c) { const u32x4 w0 = kp[c], w1 = kp[c + 4];
                const float x1[8] = {bflo(w0.x), bfhi(w0.x), bflo(w0.y), bfhi(w0.y), bflo(w0.z), bfhi(w0.z), bflo(w0.w), bfhi(w0.w)};
                const float x2[8] = {bflo(w1.x), bfhi(w1.x), bflo(w1.y), bfhi(w1.y), bflo(w1.z), bfhi(w1.z), bflo(w1.w), bfhi(w1.w)};
#pragma unroll
                for (int i = 0; i < 8; ++i) { const float cs = COS[tk * 32 + c * 8 + i], sn = SIN[tk * 32 + c * 8 + i];
                    sc += q[c * 8 + i] * (x1[i] * cs - x2[i] * sn) + q[32 + c * 8 + i] * (x2[i] * cs + x1[i] * sn); } }
            sc *= 0.125f;
            const float mn = fmaxf(m, sc), alpha = __expf(m - mn), p = __expf(sc - mn);
            lsum = lsum * alpha + p; m = mn;
            const u32x4* vp = (const u32x4*)(P + (size_t)tk * NPROJ + C_V + kvh * 64);
#pragma unroll
            for (int c = 0; c < 8; ++c) { const u32x4 w = vp[c];
                acc[c * 8 + 0] = acc[c * 8 + 0] * alpha + p * bflo(w.x); acc[c * 8 + 1] = acc[c * 8 + 1] * alpha + p * bfhi(w.x);
                acc[c * 8 + 2] = acc[c * 8 + 2] * alpha + p * bflo(w.y); acc[c * 8 + 3] = acc[c * 8 + 3] * alpha + p * bfhi(w.y);
                acc[c * 8 + 4] = acc[c * 8 + 4] * alpha + p * bflo(w.z); acc[c * 8 + 5] = acc[c * 8 + 5] * alpha + p * bfhi(w.z);
                acc[c * 8 + 6] = acc[c * 8 + 6] * alpha + p * bflo(w.w); acc[c * 8 + 7] = acc[c * 8 + 7] * alpha + p * bfhi(w.w); }
        }
        const float inv = 1.0f / lsum;
        u32x4* op = (u32x4*)(MIX + (size_t)tok * D + h * 64);
#pragma unroll
        for (int c = 0; c < 8; ++c) { u32x4 o; o.x = pk2(acc[c * 8] * inv, acc[c * 8 + 1] * inv); o.y = pk2(acc[c * 8 + 2] * inv, acc[c * 8 + 3] * inv);
            o.z = pk2(acc[c * 8 + 4] * inv, acc[c * 8 + 5] * inv); o.w = pk2(acc[c * 8 + 6] * inv, acc[c * 8 + 7] * inv); op[c] = o; }
    }
}

__device__ __forceinline__ void ssd_naive_scan(const Args& a, int l) {
    unsigned char* ws = a.ws; const bf16* P = (const bf16*)(ws + WS_PROJ); const float* DT = (const float*)(ws + WS_DT);
    float* YG = (float*)(OB(a) + DO_STATES);
    const int idx = blockIdx.x * 512 + threadIdx.x;
    if (idx >= 32768) return;
    const int nc = idx & 15, p = (idx >> 4) & 63, h = (idx >> 10) & 7, b = idx >> 13, g = h >> 2;
    const float* cw = a.in[10] + (size_t)l * 4 * 1024; const float* cb = a.in[11] + l * 1024;
    const int chx = h * 64 + p, chB = 512 + g * 128 + nc * 8, chC = 768 + g * 128 + nc * 8;
    float wx[4], wB[4][8], wC[4][8], bx, bB[8], bC[8];
#pragma unroll
    for (int k = 0; k < 4; ++k) { wx[k] = cw[k * 1024 + chx];
#pragma unroll
        for (int i = 0; i < 8; ++i) { wB[k][i] = cw[k * 1024 + chB + i]; wC[k][i] = cw[k * 1024 + chC + i]; } }
    bx = cb[chx];
#pragma unroll
    for (int i = 0; i < 8; ++i) { bB[i] = cb[chB + i]; bC[i] = cb[chC + i]; }
    float hx[3] = {0.f, 0.f, 0.f}, hB[3][8], hC[3][8], st[8];
#pragma unroll
    for (int k = 0; k < 3; ++k)
#pragma unroll
        for (int i = 0; i < 8; ++i) { hB[k][i] = 0.f; hC[k][i] = 0.f; }
#pragma unroll
    for (int i = 0; i < 8; ++i) st[i] = 0.f;
    const float aneg = -expf(a.in[13][l * 8 + h]), dsk = a.in[14][l * 8 + h];
    for (int t = 0; t < SEQ; ++t) {
        const size_t tok = (size_t)b * SEQ + t; const bf16* pr = P + tok * NPROJ;
        const float xc = bf2f(pr[C_XS + chx]);
        const u32x4 bw = *(const u32x4*)(pr + C_XS + chB), cwv = *(const u32x4*)(pr + C_XS + chC);
        const float Bc[8] = {bflo(bw.x), bfhi(bw.x), bflo(bw.y), bfhi(bw.y), bflo(bw.z), bfhi(bw.z), bflo(bw.w), bfhi(bw.w)};
        const float Cc[8] = {bflo(cwv.x), bfhi(cwv.x), bflo(cwv.y), bfhi(cwv.y), bflo(cwv.z), bfhi(cwv.z), bflo(cwv.w), bfhi(cwv.w)};
        const float xs = silu_f(wx[0] * hx[0] + wx[1] * hx[1] + wx[2] * hx[2] + wx[3] * xc + bx);
        hx[0] = hx[1]; hx[1] = hx[2]; hx[2] = xc;
        const float dt = DT[tok * 8 + h], dA = __expf(dt * aneg), xd = dt * xs;
        float yp = 0.f;
#pragma unroll
        for (int i = 0; i < 8; ++i) {
            const float Bn = silu_f(wB[0][i] * hB[0][i] + wB[1][i] * hB[1][i] + wB[2][i] * hB[2][i] + wB[3][i] * Bc[i] + bB[i]);
            const float Cn = silu_f(wC[0][i] * hC[0][i] + wC[1][i] * hC[1][i] + wC[2][i] * hC[2][i] + wC[3][i] * Cc[i] + bC[i]);
            hB[0][i] = hB[1][i]; hB[1][i] = hB[2][i]; hB[2][i] = Bc[i]; hC[0][i] = hC[1][i]; hC[1][i] = hC[2][i]; hC[2][i] = Cc[i];
            st[i] = dA * st[i] + xd * Bn; yp += Cn * st[i];
        }
        yp += __shfl_xor(yp, 1); yp += __shfl_xor(yp, 2); yp += __shfl_xor(yp, 4); yp += __shfl_xor(yp, 8);
        if (nc == 0) { const float y = yp + dsk * xs; const float z = bf2f(pr[C_Z + chx]); YG[tok * 512 + chx] = y * silu_f(z); }
    }
}
__device__ __forceinline__ void ssd_naive_norm(const Args& a, int l) {
    unsigned char* ws = a.ws; const float* YG = (const float*)(OB(a) + DO_STATES); bf16* MIX = (bf16*)(ws + WS_H);
    const int lane = threadIdx.x & 63, wave = threadIdx.x >> 6; const float* gn = a.in[15] + l * 512;
    for (int row = blockIdx.x * 8 + wave; row < T; row += gridDim.x * 8) {
        const f32x4 v0 = *(const f32x4*)(YG + (size_t)row * 512 + lane * 8), v1 = *(const f32x4*)(YG + (size_t)row * 512 + lane * 8 + 4);
        float ss = (v0.x * v0.x + v0.y * v0.y) + (v0.z * v0.z + v0.w * v0.w) + (v1.x * v1.x + v1.y * v1.y) + (v1.z * v1.z + v1.w * v1.w);
#pragma unroll
        for (int o = 1; o < 32; o <<= 1) ss += __shfl_xor(ss, o);
        const float rstd = 1.0f / sqrtf(ss * (1.0f / 256.f) + EPS);
        const f32x4 g0 = *(const f32x4*)(gn + lane * 8), g1 = *(const f32x4*)(gn + lane * 8 + 4);
        u32x4 o; const f32x4 r0 = v0 * rstd * g0, r1 = v1 * rstd * g1; o.x = pk2(r0.x, r0.y); o.y = pk2(r0.z, r0.w); o.z = pk2(r1.x, r1.y); o.w = pk2(r1.z, r1.w);
        *(u32x4*)(MIX + (size_t)row * D + 512 + lane * 8) = o;
    }
}


__device__ __forceinline__ bf16x8 mk_frag(u32x2 lo, u32x2 hi) { u32x4 t = {lo.x, lo.y, hi.x, hi.y}; return __builtin_bit_cast(bf16x8, t); }
constexpr int AT_KS = 0, AT_VT = 36864;
__device__ __forceinline__ void rope8(const u32x4 w0, const u32x4 w1, const float* cs, const float* sn, float scale, u32x4& o0, u32x4& o1) {
    const f32x4 c0 = *(const f32x4*)cs, c1 = *(const f32x4*)(cs + 4), s0 = *(const f32x4*)sn, s1 = *(const f32x4*)(sn + 4);
    const float x1[8] = {bflo(w0.x), bfhi(w0.x), bflo(w0.y), bfhi(w0.y), bflo(w0.z), bfhi(w0.z), bflo(w0.w), bfhi(w0.w)};
    const float x2[8] = {bflo(w1.x), bfhi(w1.x), bflo(w1.y), bfhi(w1.y), bflo(w1.z), bfhi(w1.z), bflo(w1.w), bfhi(w1.w)};
    const float cc[8] = {c0.x, c0.y, c0.z, c0.w, c1.x, c1.y, c1.z, c1.w}, ss[8] = {s0.x, s0.y, s0.z, s0.w, s1.x, s1.y, s1.z, s1.w};
    float y1[8], y2[8];
#pragma unroll
    for (int i = 0; i < 8; ++i) { y1[i] = (x1[i] * cc[i] - x2[i] * ss[i]) * scale; y2[i] = (x2[i] * cc[i] + x1[i] * ss[i]) * scale; }
    o0.x = pk2(y1[0], y1[1]); o0.y = pk2(y1[2], y1[3]); o0.z = pk2(y1[4], y1[5]); o0.w = pk2(y1[6], y1[7]);
    o1.x = pk2(y2[0], y2[1]); o1.y = pk2(y2[2], y2[3]); o1.z = pk2(y2[4], y2[5]); o1.w = pk2(y2[6], y2[7]);
}
__device__ __forceinline__ void rope8r(const u32x4 w0, const u32x4 w1, const float (&cc)[8], const float (&ss)[8], float scale, u32x4& o0, u32x4& o1) {
    const float x1[8] = {bflo(w0.x), bfhi(w0.x), bflo(w0.y), bfhi(w0.y), bflo(w0.z), bfhi(w0.z), bflo(w0.w), bfhi(w0.w)};
    const float x2[8] = {bflo(w1.x), bfhi(w1.x), bflo(w1.y), bfhi(w1.y), bflo(w1.z), bfhi(w1.z), bflo(w1.w), bfhi(w1.w)};
    float y1[8], y2[8];
#pragma unroll
    for (int i = 0; i < 8; ++i) { y1[i] = (x1[i] * cc[i] - x2[i] * ss[i]) * scale; y2[i] = (x2[i] * cc[i] + x1[i] * ss[i]) * scale; }
    o0.x = pk2(y1[0], y1[1]); o0.y = pk2(y1[2], y1[3]); o0.z = pk2(y1[4], y1[5]); o0.w = pk2(y1[6], y1[7]);
    o1.x = pk2(y2[0], y2[1]); o1.y = pk2(y2[2], y2[3]); o1.z = pk2(y2[4], y2[5]); o1.w = pk2(y2[6], y2[7]);
}
__device__ __forceinline__ float vmax3(float a, float b, float c) { float r; asm("v_max3_f32 %0, %1, %2, %3" : "=v"(r) : "v"(a), "v"(b), "v"(c)); return r; }
__device__ __forceinline__ void rope8v(const u32x4 w0, const u32x4 w1, const f32x4 c0, const f32x4 c1, const f32x4 s0, const f32x4 s1, float scale, u32x4& o0, u32x4& o1) {
    const float x1[8] = {bflo(w0.x), bfhi(w0.x), bflo(w0.y), bfhi(w0.y), bflo(w0.z), bfhi(w0.z), bflo(w0.w), bfhi(w0.w)};
    const float x2[8] = {bflo(w1.x), bfhi(w1.x), bflo(w1.y), bfhi(w1.y), bflo(w1.z), bfhi(w1.z), bflo(w1.w), bfhi(w1.w)};
    const float cc[8] = {c0.x, c0.y, c0.z, c0.w, c1.x, c1.y, c1.z, c1.w}, ss[8] = {s0.x, s0.y, s0.z, s0.w, s1.x, s1.y, s1.z, s1.w};
    float y1[8], y2[8];
#pragma unroll
    for (int i = 0; i < 8; ++i) { y1[i] = (x1[i] * cc[i] - x2[i] * ss[i]) * scale; y2[i] = (x2[i] * cc[i] + x1[i] * ss[i]) * scale; }
    o0.x = pk2(y1[0], y1[1]); o0.y = pk2(y1[2], y1[3]); o0.z = pk2(y1[4], y1[5]); o0.w = pk2(y1[6], y1[7]);
    o1.x = pk2(y2[0], y2[1]); o1.y = pk2(y2[2], y2[3]); o1.z = pk2(y2[4], y2[5]); o1.w = pk2(y2[6], y2[7]);
}
__device__ __forceinline__ void attn_phase(LAS unsigned char* lds, const Args& a, int l, int wv) {
    const int tid = opaque_tid(wv), lane = tid & 63, wid = __builtin_amdgcn_readfirstlane(tid >> 6), fr = lane & 15, fq = lane >> 4;
    unsigned char* ws = a.ws; const bf16* P = (const bf16*)(ws + WS_PROJ); bf16* MIX = (bf16*)(ws + WS_H);
    const float* COS = (const float*)(ws + WS_COS); const float* SIN = (const float*)(ws + WS_SIN);
    for (int i = tid; i < 64 * 8; i += 512) *(LAS unsigned*)(lds + AT_VT + (i >> 3) * 544 + 512 + (i & 7) * 4) = 0u;
    u32x4 kw0[2], kw1[2]; f32x4 kc0[2], kc1[2], ks0[2], ks1[2]; u32x4 vw[8];
    const int vt = tid - 256, vseg = vt & 31, vc = vt >> 5, vkey0 = vseg * 8;
#define AT_UNIT(u0_) ((gridDim.x == 256) ? (((u0_) & ~255) | (((u0_) & 7) << 5) | (((u0_) & 255) >> 3)) : (u0_))
#define AT_FILL_LOAD(u0_) do { const int u_ = AT_UNIT(u0_); const int kvh_ = u_ & 1, blk_ = (u_ >> 1) & 63, tok0_ = (u_ >> 7) * SEQ + blk_ * 128; \
        _Pragma("unroll") for (int it = 0; it < 2; ++it) { const int task = tid + 512 * it, key = task >> 2, c = task & 3; const bool valid = (blk_ > 0) || key >= 128; const int kt = valid ? tok0_ - 128 + key : tok0_; \
            const bf16* kp = P + (size_t)kt * NPROJ + C_K + kvh_ * 64; kw0[it] = *(const u32x4*)(kp + 8 * c); kw1[it] = *(const u32x4*)(kp + 32 + 8 * c); \
            const float* cs = COS + (size_t)kt * 32 + 8 * c; const float* sn = SIN + (size_t)kt * 32 + 8 * c; \
            kc0[it] = *(const f32x4*)cs; kc1[it] = *(const f32x4*)(cs + 4); ks0[it] = *(const f32x4*)sn; ks1[it] = *(const f32x4*)(sn + 4); } \
        if (tid >= 256) { _Pragma("unroll") for (int r = 0; r < 8; ++r) { const int key = vkey0 + r; const bool valid = (blk_ > 0) || key >= 128; const int kt = valid ? tok0_ - 128 + key : tok0_; \
            vw[r] = *(const u32x4*)(P + (size_t)kt * NPROJ + C_V + kvh_ * 64 + 8 * vc); } } } while (0)
    if ((int)blockIdx.x < 512) AT_FILL_LOAD((int)blockIdx.x);
    for (int u0 = blockIdx.x; u0 < 512; u0 += gridDim.x) {
        const int u = AT_UNIT(u0);
        const int kvh = u & 1, blk = (u >> 1) & 63, b = u >> 7;
        const int tok0 = b * SEQ + blk * 128;
        __syncthreads();
        {
#pragma unroll
            for (int it = 0; it < 2; ++it) { const int task = tid + 512 * it, key = task >> 2, c = task & 3; const bool valid = (blk > 0) || key >= 128;
                u32x4 o0, o1; rope8v(kw0[it], kw1[it], kc0[it], kc1[it], ks0[it], ks1[it], 1.0f, o0, o1);
                if (!valid) { o0 = (u32x4){0u, 0u, 0u, 0u}; o1 = (u32x4){0u, 0u, 0u, 0u}; }
                *(LAS u32x4*)(lds + AT_KS + key * 144 + c * 16) = o0; *(LAS u32x4*)(lds + AT_KS + key * 144 + 64 + c * 16) = o1; }
            if (tid >= 256) {
                u32x4 w[8];
#pragma unroll
                for (int r = 0; r < 8; ++r) { const bool valid = (blk > 0) || (vkey0 + r) >= 128; w[r] = valid ? vw[r] : (u32x4){0u, 0u, 0u, 0u}; }
#pragma unroll
                for (int i = 0; i < 8; ++i) { u32x4 o;
                    if (i & 1) { o.x = (w[0][i >> 1] >> 16) | (w[1][i >> 1] & 0xffff0000u); o.y = (w[2][i >> 1] >> 16) | (w[3][i >> 1] & 0xffff0000u); o.z = (w[4][i >> 1] >> 16) | (w[5][i >> 1] & 0xffff0000u); o.w = (w[6][i >> 1] >> 16) | (w[7][i >> 1] & 0xffff0000u); }
                    else { o.x = (w[0][i >> 1] & 0xffffu) | (w[1][i >> 1] << 16); o.y = (w[2][i >> 1] & 0xffffu) | (w[3][i >> 1] << 16); o.z = (w[4][i >> 1] & 0xffffu) | (w[5][i >> 1] << 16); o.w = (w[6][i >> 1] & 0xffffu) | (w[7][i >> 1] << 16); }
                    *(LAS u32x4*)(lds + AT_VT + (8 * vc + i) * 544 + vkey0 * 2) = o; }
            }
            asm volatile("" ::: "memory");
            if (u0 + (int)gridDim.x < 512) AT_FILL_LOAD(u0 + (int)gridDim.x);
        }
        __syncthreads();
        const int g = wid >> 1, h = kvh * 4 + g; const float sink2 = a.in[9][l * 8 + h] * 1.44269504f;
        const int mlo = fr + 1 - 4 * fq, mhi = fr - 4 * fq;
#pragma unroll 1
        for (int qt = 0; qt < 4; ++qt) {
            const int i0 = (wid & 1) * 64 + qt * 16, kt0 = i0 >> 4; const int qtok = tok0 + i0 + fr;
            bf16x8 q0, q1;
            { const bf16* qp = P + (size_t)qtok * NPROJ + C_Q + h * 64; const u32x4 w0 = *(const u32x4*)(qp + 8 * fq), w1 = *(const u32x4*)(qp + 32 + 8 * fq);
              u32x4 o0, o1; rope8(w0, w1, COS + (size_t)qtok * 32 + 8 * fq, SIN + (size_t)qtok * 32 + 8 * fq, 0.125f * 1.44269504f, o0, o1);
              q0 = __builtin_bit_cast(bf16x8, o0); q1 = __builtin_bit_cast(bf16x8, o1); }
            f32x4 sacc[9];
#pragma unroll
            for (int kt = 0; kt < 9; ++kt) { const int krow = 16 * (kt0 + kt) + fr;
                const bf16x8 k0 = *(const LAS bf16x8*)(lds + AT_KS + krow * 144 + fq * 16), k1 = *(const LAS bf16x8*)(lds + AT_KS + krow * 144 + 64 + fq * 16);
                f32x4 acc = {0.f, 0.f, 0.f, 0.f};
                acc = __builtin_amdgcn_mfma_f32_16x16x32_bf16(k0, q0, acc, 0, 0, 0); acc = __builtin_amdgcn_mfma_f32_16x16x32_bf16(k1, q1, acc, 0, 0, 0); sacc[kt] = acc; }
            float mx = sink2;
#pragma unroll
            for (int r = 0; r < 4; ++r) { sacc[0][r] = (r >= mlo) ? sacc[0][r] : -__builtin_inff(); sacc[8][r] = (r <= mhi) ? sacc[8][r] : -__builtin_inff(); }
            if (blk == 0) {
                asm volatile("; first sequence block" ::: "memory");
#pragma unroll
                for (int kt = 0; kt < 9; ++kt) if (kt0 + kt < 8) sacc[kt] = (f32x4){-__builtin_inff(), -__builtin_inff(), -__builtin_inff(), -__builtin_inff()}; }
            float mxb = -__builtin_inff();
#pragma unroll
            for (int kt = 0; kt < 9; ++kt) { mx = vmax3(mx, sacc[kt][0], sacc[kt][1]); mxb = vmax3(mxb, sacc[kt][2], sacc[kt][3]); }
            mx = vmax3(mx, mxb, mxb);
            mx = vmax3(mx, sx(mx, 16, lane), mx); mx = vmax3(mx, sx(mx, 32, lane), mx);
            const float nmx = -mx; const f32x4 mx4 = {nmx, nmx, nmx, nmx}; f32x4 sum4 = {0.f, 0.f, 0.f, 0.f};
#pragma unroll
            for (int kt = 0; kt < 9; ++kt) { const f32x4 d = sacc[kt] + mx4; f32x4 pv; pv.x = __builtin_amdgcn_exp2f(d.x); pv.y = __builtin_amdgcn_exp2f(d.y); pv.z = __builtin_amdgcn_exp2f(d.z); pv.w = __builtin_amdgcn_exp2f(d.w);
                sacc[kt] = pv; sum4 += pv; }
            float sum = (sum4.x + sum4.y) + (sum4.z + sum4.w);
            sum += sx(sum, 16, lane); sum += sx(sum, 32, lane);
            const float inv = 1.0f / (sum + __builtin_amdgcn_exp2f(sink2 - mx));
            bf16x8 pf[5];
#pragma unroll
            for (int s2 = 0; s2 < 5; ++s2) { const f32x4 pa = sacc[2 * s2]; f32x4 pb = {0.f, 0.f, 0.f, 0.f}; if (2 * s2 + 1 < 9) pb = sacc[(2 * s2 + 1) < 9 ? (2 * s2 + 1) : 8];
                pf[s2] = mk_frag(pack4(pa), pack4(pb)); }
            f32x4 o[4];
#pragma unroll
            for (int d = 0; d < 4; ++d) o[d] = (f32x4){0.f, 0.f, 0.f, 0.f};
#pragma unroll
            for (int s2 = 0; s2 < 5; ++s2)
#pragma unroll
                for (int d = 0; d < 4; ++d) { const LAS unsigned char* vb = lds + AT_VT + (16 * d + fr) * 544 + (16 * (kt0 + 2 * s2) + 4 * fq) * 2;
                    const bf16x8 vf = mk_frag(*(const LAS u32x2*)vb, *(const LAS u32x2*)(vb + 32));
                    o[d] = __builtin_amdgcn_mfma_f32_16x16x32_bf16(vf, pf[s2], o[d], 0, 0, 0); }
#pragma unroll
            for (int d = 0; d < 4; ++d) *(u32x2*)(MIX + (size_t)qtok * D + h * 64 + 16 * d + 4 * fq) = pack4(o[d] * inv);
        }
    }
}

struct Conv8W { float w[4][8]; float b[8]; };
__device__ __forceinline__ void conv8_load(Conv8W& W, const float* cw, const float* cb, int ch) {
#pragma unroll
    for (int k = 0; k < 4; ++k) { const f32x4 x = *(const f32x4*)(cw + k * 1024 + ch), y = *(const f32x4*)(cw + k * 1024 + ch + 4);
        W.w[k][0] = x.x; W.w[k][1] = x.y; W.w[k][2] = x.z; W.w[k][3] = x.w; W.w[k][4] = y.x; W.w[k][5] = y.y; W.w[k][6] = y.z; W.w[k][7] = y.w; }
    const f32x4 x = *(const f32x4*)(cb + ch), y = *(const f32x4*)(cb + ch + 4);
    W.b[0] = x.x; W.b[1] = x.y; W.b[2] = x.z; W.b[3] = x.w; W.b[4] = y.x; W.b[5] = y.y; W.b[6] = y.z; W.b[7] = y.w;
}
__device__ __forceinline__ void conv8_apply(const Conv8W& W, const bf16* P, size_t tok, int spos, int col, float (&out)[8]) {
    u32x4 r[4];
#pragma unroll
    for (int k = 0; k < 4; ++k) { const int d = 3 - k; r[k] = (u32x4){0u, 0u, 0u, 0u}; if (spos >= d) r[k] = *(const u32x4*)(P + (tok - d) * NPROJ + col); }
#pragma unroll
    for (int i = 0; i < 8; ++i) out[i] = W.b[i];
#pragma unroll
    for (int k = 0; k < 4; ++k) { const float x[8] = {bflo(r[k].x), bfhi(r[k].x), bflo(r[k].y), bfhi(r[k].y), bflo(r[k].z), bfhi(r[k].z), bflo(r[k].w), bfhi(r[k].w)};
#pragma unroll
        for (int i = 0; i < 8; ++i) out[i] += W.w[k][i] * x[i]; }
#pragma unroll
    for (int i = 0; i < 8; ++i) out[i] = silu_f(out[i]);
}
__device__ __forceinline__ void conv_seg8(const bf16* P, size_t tok0, int cidx, int l0, int col, const float* cw, const float* cb, int ch, float (&out)[8][8]) {
    u32x4 x[11];
#pragma unroll
    for (int j = 0; j < 11; ++j) { const int lr = l0 - 3 + j; x[j] = (u32x4){0u, 0u, 0u, 0u}; if (cidx * 128 + lr >= 0) x[j] = *(const u32x4*)(P + (size_t)((long)tok0 + lr) * NPROJ + col); }
    Conv8W W; conv8_load(W, cw, cb, ch);
#pragma unroll
    for (int m = 0; m < 4; ++m) { f32x2 xp[11];
#pragma unroll
        for (int j = 0; j < 11; ++j) { xp[j].x = bflo(x[j][m]); xp[j].y = bfhi(x[j][m]); }
        const f32x2 w0 = {W.w[0][2 * m], W.w[0][2 * m + 1]}, w1 = {W.w[1][2 * m], W.w[1][2 * m + 1]}, w2 = {W.w[2][2 * m], W.w[2][2 * m + 1]}, w3 = {W.w[3][2 * m], W.w[3][2 * m + 1]}, bb = {W.b[2 * m], W.b[2 * m + 1]};
#pragma unroll
        for (int r = 0; r < 8; ++r) { f32x2 acc = w0 * xp[r] + bb; acc = w1 * xp[r + 1] + acc; acc = w2 * xp[r + 2] + acc; acc = w3 * xp[r + 3] + acc;
            const f32x2 t = acc * (-1.44269504f); f32x2 e; e.x = __builtin_amdgcn_exp2f(t.x); e.y = __builtin_amdgcn_exp2f(t.y);
            const f32x2 d = e + 1.0f; f32x2 q; q.x = __builtin_amdgcn_rcpf(d.x); q.y = __builtin_amdgcn_rcpf(d.y);
            const f32x2 o = acc * q; out[r][2 * m] = o.x; out[r][2 * m + 1] = o.y; } }
}
constexpr int SROW = 272;
__device__ __forceinline__ u32x4 pk8(const float (&o)[8]) { u32x4 w; w.x = cvt_pk_bf16(o[0], o[1]); w.y = cvt_pk_bf16(o[2], o[3]); w.z = cvt_pk_bf16(o[4], o[5]); w.w = cvt_pk_bf16(o[6], o[7]); return w; }
constexpr int S1_XD = 0, S1_BT = 69632, S1_DT = 104448, S1_ACS = 106496, S1_WD = 108544;
__device__ __forceinline__ void ssd1_phase(LAS unsigned char* lds, const Args& a, int l, int wv) {
    const int tid = opaque_tid(wv), lane = tid & 63, wid = __builtin_amdgcn_readfirstlane(tid >> 6), fr = lane & 15, fq = lane >> 4;
    unsigned char* ws = a.ws; const bf16* P = (const bf16*)(ws + WS_PROJ); const float* DT = (const float*)(ws + WS_DT);
    float* ACS = (float*)(ws + WS_ACS); float* CDEC = (float*)(ws + WS_CDEC); bf16* STATES = (bf16*)(OB(a) + DO_STATES);
    bf16* BCA = (bf16*)(OB(a) + DO_BCA); bf16* XDT = (bf16*)(OB(a) + DO_XDT);
    const float* cw = a.in[10] + (size_t)l * 4096; const float* cb = a.in[11] + l * 1024;
    LAS float* dts = (LAS float*)(lds + S1_DT); LAS float* acs = (LAS float*)(lds + S1_ACS); LAS float* wdec = (LAS float*)(lds + S1_WD);
    for (int u = blockIdx.x; u < 512; u += gridDim.x) {
        const int g = u & 1, c = (u >> 1) & 63, b = u >> 7; const size_t tok0 = (size_t)b * SEQ + c * 128;
        __syncthreads();
        if (wid < 4) {
            const int h = 4 * g + wid; const float aneg = -expf(a.in[13][l * 8 + h]); const int t0 = 2 * lane;
            const float dt0 = DT[(tok0 + t0) * 8 + h], dt1 = DT[(tok0 + t0 + 1) * 8 + h]; const float x0 = dt0 * aneg, x1 = dt1 * aneg;
            float sc = x0 + x1;
#pragma unroll 1
            for (int o = 1; o < 64; o <<= 1) { const float t = sfrom(sc, lane - o); if (lane >= o) sc += t; }
            const float acs1 = sc, acs0 = sc - x1; const float alast = sfrom(sc, 63);
            dts[wid * 128 + t0] = dt0; dts[wid * 128 + t0 + 1] = dt1; acs[wid * 128 + t0] = acs0; acs[wid * 128 + t0 + 1] = acs1;
            wdec[wid * 128 + t0] = __expf(alast - acs0); wdec[wid * 128 + t0 + 1] = __expf(alast - acs1);
            ACS[(tok0 + t0) * 8 + h] = acs0; ACS[(tok0 + t0 + 1) * 8 + h] = acs1;
            if (lane == 63) CDEC[(size_t)(b * 64 + c) * 8 + h] = expf(acs1);
        }
        __syncthreads();
        { const int seg = tid & 15, chunk = tid >> 4, hh = chunk >> 3, l0 = seg * 8; float o[8][8];
          conv_seg8(P, tok0, c, l0, C_XS + g * 256 + chunk * 8, cw, cb, g * 256 + chunk * 8, o);
          const f32x4 d0 = *(const LAS f32x4*)(dts + hh * 128 + l0), d1 = *(const LAS f32x4*)(dts + hh * 128 + l0 + 4);
#pragma unroll
          for (int i = 0; i < 8; ++i) { u32x4 w; w.x = cvt_pk_bf16(o[0][i] * d0.x, o[1][i] * d0.y); w.y = cvt_pk_bf16(o[2][i] * d0.z, o[3][i] * d0.w);
              w.z = cvt_pk_bf16(o[4][i] * d1.x, o[5][i] * d1.y); w.w = cvt_pk_bf16(o[6][i] * d1.z, o[7][i] * d1.w);
              *(LAS u32x4*)(lds + S1_XD + (chunk * 8 + i) * SROW + l0 * 2) = w; } }
        { const int t = tid & 255, isC = tid >> 8, seg = t & 15, chunk = t >> 4, l0 = seg * 8; float o[8][8];
          conv_seg8(P, tok0, c, l0, (isC ? C_C : C_B) + g * 128 + chunk * 8, cw, cb, (isC ? 768 : 512) + g * 128 + chunk * 8, o);
#pragma unroll
          for (int r = 0; r < 8; ++r) *(u32x4*)(BCA + (tok0 + l0 + r) * 512 + g * 256 + isC * 128 + chunk * 8) = pk8(o[r]);
          if (!isC) {
#pragma unroll
              for (int i = 0; i < 8; ++i) { u32x4 w; w.x = cvt_pk_bf16(o[0][i], o[1][i]); w.y = cvt_pk_bf16(o[2][i], o[3][i]); w.z = cvt_pk_bf16(o[4][i], o[5][i]); w.w = cvt_pk_bf16(o[6][i], o[7][i]);
                  *(LAS u32x4*)(lds + S1_BT + (chunk * 8 + i) * SROW + l0 * 2) = w; } } }
        __syncthreads();
        const int hh = wid >> 1, pt0 = (wid & 1) * 2;
        f32x4 acc[2][8];
#pragma unroll
        for (int pi = 0; pi < 2; ++pi)
#pragma unroll
            for (int nt = 0; nt < 8; ++nt) acc[pi][nt] = (f32x4){0.f, 0.f, 0.f, 0.f};
#pragma unroll
        for (int ks = 0; ks < 4; ++ks) {
            const f32x4 wl = *(const LAS f32x4*)(wdec + hh * 128 + 32 * ks + 4 * fq), wh = *(const LAS f32x4*)(wdec + hh * 128 + 32 * ks + 16 + 4 * fq);
            bf16x8 xf[2];
#pragma unroll
            for (int pi = 0; pi < 2; ++pi) { const LAS unsigned char* ab = lds + S1_XD + (hh * 64 + 16 * (pt0 + pi) + fr) * SROW + (32 * ks + 4 * fq) * 2;
                const u32x2 lo = *(const LAS u32x2*)ab, hi = *(const LAS u32x2*)(ab + 32);
                u32x2 lo2, hi2; lo2.x = cvt_pk_bf16(bflo(lo.x) * wl.x, bfhi(lo.x) * wl.y); lo2.y = cvt_pk_bf16(bflo(lo.y) * wl.z, bfhi(lo.y) * wl.w);
                hi2.x = cvt_pk_bf16(bflo(hi.x) * wh.x, bfhi(hi.x) * wh.y); hi2.y = cvt_pk_bf16(bflo(hi.y) * wh.z, bfhi(hi.y) * wh.w);
                xf[pi] = mk_frag(lo2, hi2); }
#pragma unroll
            for (int nt = 0; nt < 8; ++nt) { const LAS unsigned char* bb = lds + S1_BT + (16 * nt + fr) * SROW + (32 * ks + 4 * fq) * 2;
                const bf16x8 bfg = mk_frag(*(const LAS u32x2*)bb, *(const LAS u32x2*)(bb + 32));
#pragma unroll
                for (int pi = 0; pi < 2; ++pi) acc[pi][nt] = __builtin_amdgcn_mfma_f32_16x16x32_bf16(bfg, xf[pi], acc[pi][nt], 0, 0, 0); }
        }
        bf16* sp = STATES + ((size_t)((b * 64 + c) * 8 + 4 * g + hh) * 64) * 128;
#pragma unroll
        for (int pi = 0; pi < 2; ++pi)
#pragma unroll
            for (int nt = 0; nt < 8; ++nt) *(u32x2*)(sp + (size_t)(16 * (pt0 + pi) + fr) * 128 + 16 * nt + 4 * fq) = pack4(acc[pi][nt]);
        { bf16* xg = XDT + (size_t)((b * 64 + c) * 2 + g) * 256 * 128;
#pragma unroll
          for (int it = 0; it < 8; ++it) { const int task = tid + 512 * it, row = task >> 4, c16 = task & 15;
              *(u32x4*)(xg + row * 128 + c16 * 8) = *(const LAS u32x4*)(lds + S1_XD + row * SROW + c16 * 16); } }
    }
}
__device__ __forceinline__ void ssd2_phase(const Args& a, int wv) {
    unsigned char* ws = a.ws; const unsigned* STATES = (const unsigned*)(OB(a) + DO_STATES); const float* CDEC = (const float*)(ws + WS_CDEC); unsigned* HPREV = (unsigned*)(OB(a) + DO_HPREV);
    for (int idx = blockIdx.x * 512 + opaque_tid(wv); idx < 131072; idx += gridDim.x * 512) {
        const int n2 = idx & 63, p = (idx >> 6) & 63, h = (idx >> 12) & 7, b = idx >> 15;
        float s0 = 0.f, s1 = 0.f;
#pragma unroll 1
        for (int c0 = 0; c0 < 64; c0 += 16) {
            unsigned sv[16]; float dec[16];
#pragma unroll
            for (int k = 0; k < 16; ++k) { const size_t base = ((size_t)((b * 64 + c0 + k) * 8 + h) * 64 + p) * 64 + n2; sv[k] = STATES[base]; dec[k] = CDEC[(size_t)(b * 64 + c0 + k) * 8 + h]; }
            asm volatile("" ::: "memory");
#pragma unroll
            for (int k = 0; k < 16; ++k) { const size_t base = ((size_t)((b * 64 + c0 + k) * 8 + h) * 64 + p) * 64 + n2;
                HPREV[base] = cvt_pk_bf16(s0, s1); s0 = dec[k] * s0 + bflo(sv[k]); s1 = dec[k] * s1 + bfhi(sv[k]); }
        }
    }
}
constexpr int S3_BS = 0, S3_CS = 34816, S3_HP = 0, S3_XD = 69632, S3_DT = 139264, S3_ACS = 141312, S3_GN = 143360;
__device__ __forceinline__ void ssd3_phase(LAS unsigned char* lds, const Args& a, int l, int dry, int wv) {
    const int tid = opaque_tid(wv), lane = tid & 63, wid = __builtin_amdgcn_readfirstlane(tid >> 6), fr = lane & 15, fq = lane >> 4;
    unsigned char* ws = a.ws; const bf16* P = (const bf16*)(ws + WS_PROJ); const float* DT = (const float*)(ws + WS_DT);
    const float* ACS = (const float*)(ws + WS_ACS); const bf16* HPREV = (const bf16*)(OB(a) + DO_HPREV); bf16* MIX = (bf16*)(ws + WS_H);
    const bf16* BCA = (const bf16*)(OB(a) + DO_BCA); const bf16* XDT = (const bf16*)(OB(a) + DO_XDT);
    LAS float* dts = (LAS float*)(lds + S3_DT); LAS float* acs = (LAS float*)(lds + S3_ACS);
    for (int u = blockIdx.x; u < 512; u += gridDim.x) {
        const int g = u & 1, c = (u >> 1) & 63, b = u >> 7; const size_t tok0 = (size_t)b * SEQ + c * 128;
        __syncthreads();
        { const int hh = tid >> 7, lr = tid & 127; const float dv = DT[(tok0 + lr) * 8 + 4 * g + hh], av = ACS[(tok0 + lr) * 8 + 4 * g + hh]; const float gnv = a.in[15][l * 512 + g * 256 + (tid & 255)];
          asm volatile("" ::: "memory"); dts[tid] = dv; acs[tid] = av; if (tid < 256) ((LAS float*)(lds + S3_GN))[tid] = gnv; }
        { u32x4 wb[8], wx[8];
          const bf16* xg = XDT + (size_t)((b * 64 + c) * 2 + g) * 256 * 128;
#pragma unroll
          for (int it = 0; it < 8; ++it) { const int task = tid + 512 * it; wb[it] = *(const u32x4*)(BCA + (tok0 + (task >> 5)) * 512 + g * 256 + (task & 31) * 8);
              wx[it] = *(const u32x4*)(xg + (task >> 4) * 128 + (task & 15) * 8); }
          asm volatile("" ::: "memory");
#pragma unroll
          for (int it = 0; it < 8; ++it) { const int task = tid + 512 * it, row = task >> 5, c16 = task & 31;
              *(LAS u32x4*)(lds + (c16 < 16 ? S3_BS : S3_CS) + row * SROW + (c16 & 15) * 16) = wb[it];
              *(LAS u32x4*)(lds + S3_XD + (task >> 4) * SROW + (task & 15) * 16) = wx[it]; } }
        __syncthreads();
        if (dry == 2) continue;
        u32x4 hpr[8];
        { const bf16* hp = HPREV + (size_t)((b * 64 + c) * 8 + 4 * g) * 64 * 128;
#pragma unroll
          for (int it = 0; it < 8; ++it) { const int task = tid + 512 * it, row = task >> 4, c16 = task & 15; hpr[it] = *(const u32x4*)(hp + row * 128 + c16 * 8); } }
        bf16x8 cfr[4];
#pragma unroll
        for (int ks = 0; ks < 4; ++ks) cfr[ks] = *(const LAS bf16x8*)(lds + S3_CS + (16 * wid + fr) * SROW + (32 * ks + 8 * fq) * 2);
        f32x4 cbt[8];
#pragma unroll
        for (int st = 0; st < 8; ++st) { f32x4 acc = {0.f, 0.f, 0.f, 0.f};
            if (st <= wid) {
#pragma unroll
                for (int ks = 0; ks < 4; ++ks) { const bf16x8 bfA = *(const LAS bf16x8*)(lds + S3_BS + (16 * st + fr) * SROW + (32 * ks + 8 * fq) * 2);
                    acc = __builtin_amdgcn_mfma_f32_16x16x32_bf16(bfA, cfr[ks], acc, 0, 0, 0); } }
            cbt[st] = acc; }
        __syncthreads();
#pragma unroll
        for (int it = 0; it < 8; ++it) { const int task = tid + 512 * it, row = task >> 4, c16 = task & 15; *(LAS u32x4*)(lds + S3_HP + row * SROW + c16 * 16) = hpr[it]; }
        __syncthreads();
        if (dry == 1) continue;
        const size_t qtok = tok0 + 16 * wid + fr;
        float ss = 0.f;
        u32x2 Y[4][4];
#pragma unroll
        for (int q = 0; q < 4; ++q)
#pragma unroll
            for (int pt = 0; pt < 4; ++pt) Y[q][pt] = (u32x2){0u, 0u};
#pragma unroll 1
        for (int hh = 0; hh < 4; ++hh) {
            const int h = 4 * g + hh;
            u32x2 zw[4];
#pragma unroll
            for (int pt = 0; pt < 4; ++pt) zw[pt] = *(const u32x2*)(P + qtok * NPROJ + C_Z + h * 64 + 16 * pt + 4 * fq);
            const float acs_l = acs[hh * 128 + 16 * wid + fr], dt_l = dts[hh * 128 + 16 * wid + fr], dsk = a.in[14][l * 8 + h];
            const float ddiag = dsk / dt_l;
            bf16x8 mf[4];
#pragma unroll
            for (int s2 = 0; s2 < 4; ++s2) {
                f32x4 mv[2];
#pragma unroll
                for (int q = 0; q < 2; ++q) { const int tile = 2 * s2 + q; f32x4 v = {0.f, 0.f, 0.f, 0.f};
                    if (tile <= wid) { const f32x4 as = *(const LAS f32x4*)(acs + hh * 128 + 16 * tile + 4 * fq);
#pragma unroll
                        for (int r = 0; r < 4; ++r) { const int sidx = 16 * tile + 4 * fq + r, lidx = 16 * wid + fr;
                            float val = (sidx <= lidx) ? cbt[tile][r] * __expf(acs_l - as[r]) : 0.f; if (sidx == lidx) val += ddiag; v[r] = val; } }
                    mv[q] = v; }
                mf[s2] = mk_frag(pack4(mv[0]), pack4(mv[1])); }
            f32x4 y[4], yo[4];
#pragma unroll
            for (int pt = 0; pt < 4; ++pt) { y[pt] = (f32x4){0.f, 0.f, 0.f, 0.f}; yo[pt] = (f32x4){0.f, 0.f, 0.f, 0.f}; }
#pragma unroll
            for (int s2 = 0; s2 < 4; ++s2) if (2 * s2 <= wid) {
#pragma unroll
                for (int pt = 0; pt < 4; ++pt) { const LAS unsigned char* ab = lds + S3_XD + (hh * 64 + 16 * pt + fr) * SROW + (32 * s2 + 4 * fq) * 2;
                    y[pt] = __builtin_amdgcn_mfma_f32_16x16x32_bf16(mk_frag(*(const LAS u32x2*)ab, *(const LAS u32x2*)(ab + 32)), mf[s2], y[pt], 0, 0, 0); } }
#pragma unroll
            for (int ks = 0; ks < 4; ++ks)
#pragma unroll
                for (int pt = 0; pt < 4; ++pt) { const bf16x8 hf = *(const LAS bf16x8*)(lds + S3_HP + (hh * 64 + 16 * pt + fr) * SROW + (32 * ks + 8 * fq) * 2);
                    yo[pt] = __builtin_amdgcn_mfma_f32_16x16x32_bf16(hf, cfr[ks], yo[pt], 0, 0, 0); }
            const float el = __expf(acs_l);
#pragma unroll
            for (int pt = 0; pt < 4; ++pt) {
                f32x4 v = y[pt] + yo[pt] * el; v.x *= silu_fast(bflo(zw[pt].x)); v.y *= silu_fast(bfhi(zw[pt].x)); v.z *= silu_fast(bflo(zw[pt].y)); v.w *= silu_fast(bfhi(zw[pt].y));
                ss += (v.x * v.x + v.y * v.y) + (v.z * v.z + v.w * v.w); const u32x2 pv = pack4(v);
#pragma unroll
                for (int q = 0; q < 4; ++q) { Y[q][pt].x = (hh == q) ? pv.x : Y[q][pt].x; Y[q][pt].y = (hh == q) ? pv.y : Y[q][pt].y; } }
        }
        ss += sx(ss, 16, lane); ss += sx(ss, 32, lane);
        const float rstd = 1.0f / sqrtf(ss * (1.0f / 256.f) + EPS);
        const LAS float* gn = (const LAS float*)(lds + S3_GN);
#pragma unroll
        for (int i = 0; i < 16; ++i) { const int hh = i >> 2, pt = i & 3; const f32x4 gv = *(const LAS f32x4*)(gn + hh * 64 + 16 * pt + 4 * fq);
            const u32x2 w = Y[hh][pt]; const f32x4 v = {bflo(w.x), bfhi(w.x), bflo(w.y), bfhi(w.y)};
            *(u32x2*)(MIX + qtok * D + 512 + g * 256 + hh * 64 + 16 * pt + 4 * fq) = pack4(v * rstd * gv); }
    }
}

constexpr int NPHASES = 1 + 7 + 2 + 7 + 1 + NCHUNK + 1;

__global__ void __launch_bounds__(512, 2) mk(Args a) {
    extern __shared__ __attribute__((aligned(16))) unsigned char lds_raw[];
    LAS unsigned char* lds = (LAS unsigned char*)lds_raw;
    volatile LAS unsigned* MISC = (volatile LAS unsigned*)(lds + MISC_OFF);
#if !defined(PROBE_LO)
    const int lo = a.ph_lo, hi = a.ph_hi;
#endif
    unsigned char* ws = a.ws;
    if (FP8_SAT_MODE) __builtin_amdgcn_s_setreg(1 | (23 << 6), 1);
    const int wv = __builtin_amdgcn_readfirstlane((int)threadIdx.x >> 6);
    if (wv == 0) MISC[lane_id()] = 0u;
    __syncthreads();
    XcdBarrier bar; bar.bar = (unsigned*)(ws + WS_CTL) + 4096; bar.x = 0; bar.st = MISC + 8; bar.wv = wv;
    if (a.ph_hi - a.ph_lo > 1) bar = xcd_barrier_post((unsigned*)(ws + WS_CTL) + 4096, MISC + 8, wv);
#if defined(PROBE_LO)
#ifndef PROBE_DRY
#define PROBE_DRY 0
#endif
#define DRYV ((pass == 1 && ph < PROBE_HI) ? PROBE_DRY : 0)
  for (int pass = 0; pass < 2; ++pass) {
    const int lo = pass == 0 ? 0 : PROBE_LO, hi = pass == 0 ? PROBE_HI : NPHASES;
    if (pass == 1) xcd_barrier(bar);
#endif
#if !defined(PROBE_LO)
#define DRYV 0
#endif
    int ph = 0;
#define PH_BEGIN if (ph >= lo && ph < hi) {
#define PH_END   if (ph + 1 < hi) { \
        if (!MK_MULTI && ph < TR_BG_NBAR && gridDim.x == 256) XCD_BARRIER_BG(bar, tr_range(lds, a, wv, TR_BG0 + ph * TR_BG_PER, TR_BG0 + (ph + 1) * TR_BG_PER, (int)blockIdx.x * 7 + wv - 1, 256 * 7)); \
        else xcd_barrier(bar); } } ++ph;

    PH_BEGIN prologue_phase(lds, a, wv); PH_END

#pragma unroll 1
    for (int l = 0; l < 2; ++l) {
        const float* Xcur = (l == 0) ? a.in[0] : (const float*)a.out;
        const float* modl = (const float*)(ws + WS_MOD) + (size_t)l * 4 * 6144;
        PH_BEGIN { if (l == 0) norm_phase<0, false, false, true>(lds, a, l, a.in[0], nullptr, wv); else norm_phase<0, false, true>(lds, a, l, ws + WS_XB, nullptr, wv); } PH_END
        PH_BEGIN {
            GemmProb g{(const bf16*)(ws + WS_H), D, (const bf16*)(ws + WS_WIN) + (size_t)l * NPROJ * 1024, 0, nullptr, nullptr, 0, T, 0, NPROJ / 256, 1024, DRYV, WGM_DEF, 0, 0, 1};
            EpiStore E{(bf16*)(ws + WS_PROJ), NPROJ};
            gemm_run<EpiStore, false>(lds, g, E, wv);
            if ((int)blockIdx.x >= 128 && gridDim.x == 256)
                tr_range(lds, a, wv, TR_PRO_END + l * TR_DEFER, TR_PRO_END + (l + 1) * TR_DEFER, ((int)blockIdx.x - 128) * 8 + (opaque_tid(wv) >> 6), 128 * 8);
        } PH_END
        PH_BEGIN {
#if FAST_ATTN
            attn_phase(lds, a, l, wv);
#endif
#if FAST_SSD
            ssd1_phase(lds, a, l, wv);
#endif
        } PH_END
        PH_BEGIN {
#if FAST_SSD
            ssd2_phase(a, wv);
#endif
        } PH_END
        PH_BEGIN {
#if FAST_SSD
            ssd3_phase(lds, a, l, DRYV, wv);
#endif
        } PH_END
        PH_BEGIN {
            GemmProb g{(const bf16*)(ws + WS_H), D, (const bf16*)(ws + WS_WOUT) + (size_t)l * 1024 * 1024, 0, nullptr, nullptr, 0, T, 0, 4, 1024, DRYV, WGM_DEF, 0, 0, 1};
            EpiResid E{(bf16*)(ws + WS_XB), modl + 2 * 1024};
            gemm_run<EpiResid, false>(lds, g, E, wv);
        } PH_END
        if (l == 0) {
            PH_BEGIN norm_phase<1, false, true>(lds, a, l, ws + WS_XB, nullptr, wv); PH_END
            PH_BEGIN {
#if DENSE_GU_FP8
                GemmProb g{ws + WS_H8, D, ws + WS_WFGU, 0, nullptr, nullptr, 0, T, 0, 2 * FFN / 256, 1024, DRYV, WGM_DEF, E8_W, E8_ONE, 1};
#if DENSE_DOWN_FP8
                EpiGU8 E{ws + WS_ACT, FFN, 0};
                gemm_run<EpiGU8, false, true>(lds, g, E, wv);
#else
                EpiGU E{(bf16*)(ws + WS_ACT), FFN, 0};
                gemm_run<EpiGU, false, true>(lds, g, E, wv);
#endif
#else
                GemmProb g{(const bf16*)(ws + WS_H), D, (const bf16*)(ws + WS_WFGU), 0, nullptr, nullptr, 0, T, 0, 2 * FFN / 256, 1024, DRYV, WGM_DEF, 0, 0, 1};
                EpiGU E{(bf16*)(ws + WS_ACT), FFN, 0};
                gemm_run<EpiGU, false>(lds, g, E, wv);
#endif
            } PH_END
            PH_BEGIN {
#if DENSE_DOWN_FP8
                GemmProb g{ws + WS_ACT, FFN, ws + WS_WFD, 0, nullptr, nullptr, 0, T, 0, 4, FFN, DRYV, WGM_DEF, E8_W, E8_ACT, 1};
#else
                GemmProb g{(const bf16*)(ws + WS_ACT), FFN, (const bf16*)(ws + WS_WFD), 0, nullptr, nullptr, 0, T, 0, 4, FFN, DRYV, WGM_DEF, 0, 0, 1};
#endif
                EpiResid E{(bf16*)(ws + WS_XB), (const float*)(ws + WS_MOD) + 5 * 1024};
                gemm_run<EpiResid, false, DENSE_DOWN_FP8 != 0>(lds, g, E, wv);
            } PH_END
        } else {
            PH_BEGIN norm_phase<2, false, true>(lds, a, l, ws + WS_XB, nullptr, wv); PH_END
            PH_BEGIN route_phase(lds, a, wv); PH_END
#pragma unroll 1
            for (int j = 0; j < NCHUNK; ++j) {
                const int* meta = (const int*)(ws + WS_META);
                PH_BEGIN {
                    const int nblk = meta[8];
                    const int tb0 = (NCHUNK - 1) * CHB, tb1 = nblk;
                    unsigned char* act_t = OB(a) + DO_ACTM + 2 * ACTM_BYTES;
                    if (j >= 1) {
                        const int jj = j - 1, b0 = jj * CHB, b1 = nblk < b0 + CHB ? nblk : b0 + CHB;
                        unsigned char* act = OB(a) + DO_ACTM + (size_t)(jj & 1) * ACTM_BYTES;
                        if (b1 > b0) {
                            GemmProb g{act, EXPD, ws + WS_WMD, (size_t)1024 * EXPD, nullptr, meta, b0 * 256, (b1 - b0) * 256, b0 * 256, 4, EXPD, DRYV, WGM_DEF, E8_W, E8_ACT, 1};
                            EpiStore E{(bf16*)(ws + WS_Y), D};
                            gemm_run<EpiStore, false, true>(lds, g, E, wv);
                        }
                    }
                    if (j == NCHUNK - 1 && tb1 > tb0) {
                        GemmProb g{act_t, EXPD, ws + WS_WMD, (size_t)1024 * EXPD, nullptr, meta, tb0 * 256, (tb1 - tb0) * 256, tb0 * 256, 4, EXPD, DRYV, WGM_DEF, E8_W, E8_ACT, TAIL_KS};
                        EpiSplit E{(bf16*)(ws + WS_PART), D, 4, (size_t)TAIL_ROWS * D, tb0 * 256};
                        gemm_run<EpiSplit, false, true>(lds, g, E, wv);
                    }
                    if (j < NCHUNK - 1) {
                        const int b0 = j * CHB, b1 = nblk < b0 + CHB ? nblk : b0 + CHB;
                        unsigned char* act = OB(a) + DO_ACTM + (size_t)(j & 1) * ACTM_BYTES;
                        if (b1 > b0) {
                            GemmProb g{ws + WS_H8, D, ws + WS_WMGU, (size_t)7168 * 1024, (const int*)(ws + WS_ROWTOK), meta, b0 * 256, (b1 - b0) * 256, 0, 2 * EXPD / 256, 1024, DRYV, WGM_GU, E8_W, E8_ONE, 1};
                            EpiGU8 E{act, EXPD, b0 * 256};
                            gemm_run<EpiGU8, true, true>(lds, g, E, wv);
                        }
                    }
                    if (j == NCHUNK - 2 && tb1 > tb0) {
                        GemmProb g{ws + WS_H8, D, ws + WS_WMGU, (size_t)7168 * 1024, (const int*)(ws + WS_ROWTOK), meta, tb0 * 256, (tb1 - tb0) * 256, 0, 2 * EXPD / 256, 1024, DRYV, WGM_GU, E8_W, E8_ONE, 1};
                        EpiGU8 E{act_t, EXPD, tb0 * 256};
                        gemm_run<EpiGU8, true, true>(lds, g, E, wv);
                    }
                } PH_END
            }
        }
    }
    PH_BEGIN final_phase(a, wv); PH_END
#if defined(PROBE_LO)
  }
#endif
}

__global__ void __launch_bounds__(512, 2) k_attn_naive(Args a, int l) { attn_naive(a, l); }
__global__ void __launch_bounds__(512, 2) k_ssd_naive_scan(Args a, int l) { ssd_naive_scan(a, l); }
__global__ void __launch_bounds__(512, 2) k_ssd_naive_norm(Args a, int l) { ssd_naive_norm(a, l); }
constexpr int PH_BASE0 = 1, PH_BASE1 = 11;

extern "C" void kernel_launch(void* const* d_in, const int* in_sizes, int n_in, void* d_out, int out_size, void* d_ws, size_t ws_size, hipStream_t stream) {
    static int ready = 0;
    if (!ready) {
        if (n_in != 24 || out_size != T * D || ws_size < WS_END) { fprintf(stderr, "kernel_launch: unexpected problem (n_in %d out %d ws %zu)\n", n_in, out_size, ws_size); ready = -1; return; }
        if (hipFuncSetAttribute((const void*)mk, hipFuncAttributeMaxDynamicSharedMemorySize, LDS_BYTES) != hipSuccess) { fprintf(stderr, "kernel_launch: hipFuncSetAttribute failed\n"); ready = -1; return; }
        ready = 1;
    }
    if (ready < 0) return;
    (void)in_sizes;
    (void)hipMemsetAsync((char*)d_ws + WS_CTL, 0, CTL_BYTES, stream);
    Args a{};
    for (int i = 0; i < 24; ++i) a.in[i] = (const float*)d_in[i];
    a.out = (float*)d_out; a.ws = (unsigned char*)d_ws;
    const int grid = 256;
#if MK_MULTI
    for (int ph = 0; ph < NPHASES; ++ph) {
        int l = -1, off = -1;
        if (ph >= PH_BASE0 && ph < PH_BASE0 + 7) { l = 0; off = ph - PH_BASE0; }
        if (ph >= PH_BASE1 && ph < PH_BASE1 + 7) { l = 1; off = ph - PH_BASE1; }
        if (off == 2) {
#if !FAST_ATTN
            hipLaunchKernelGGL(k_attn_naive, dim3(grid), dim3(512), 0, stream, a, l);
#endif
#if !FAST_SSD
            hipLaunchKernelGGL(k_ssd_naive_scan, dim3(64), dim3(512), 0, stream, a, l);
#endif
        }
#if !FAST_SSD
        if (off == 3) hipLaunchKernelGGL(k_ssd_naive_norm, dim3(grid), dim3(512), 0, stream, a, l);
#endif
        a.ph_lo = ph; a.ph_hi = ph + 1; hipLaunchKernelGGL(mk, dim3(grid), dim3(512), LDS_BYTES, stream, a);
    }
#else
    a.ph_lo = 0; a.ph_hi = NPHASES; hipLaunchKernelGGL(mk, dim3(grid), dim3(512), LDS_BYTES, stream, a);
#endif
}
```
